# Optimizing an MI355X kernel written in HIP

```python
import math
import jax, jax.numpy as jnp
from jax import lax
import numpy as np

D_MODEL = 2048
BATCH = 4
SEQ = 2048
DEPTH = 1
DEC_BATCH = 128
DEC_SEQ = 8
PAST_LEN = 16384
PAGE_SIZE = 128

N_META = 16
D_FF = 5632
S5_WIDTH = D_MODEL // 2
S5_GROUP = 16
S5_GROUPS = S5_WIDTH // S5_GROUP
S5_STATE = 64
MLSTM_HEADS = 4
MLSTM_DQK = D_MODEL // 16
MLSTM_DV = D_MODEL // 8
QK_WIDTH = 2 * MLSTM_HEADS * MLSTM_DQK
V_WIDTH = MLSTM_HEADS * MLSTM_DV
CONV_W = 4
CHUNK = 64
N_BRANCH = 2
IN_WIDTH = S5_WIDTH + QK_WIDTH + 2 * V_WIDTH + 2 * MLSTM_HEADS + N_BRANCH * D_MODEL
EPS = 1e-6
DT_MIN = 1e-3
DT_MAX = 1e-1

kernel_name = 'hybrid_s5_mlstm_macaron_decode_step'


def rmsnorm(x, g):
    xf = x.astype(jnp.float32)
    y = xf * lax.rsqrt(jnp.mean(xf * xf, axis=-1, keepdims=True) + EPS)
    return (y * g.astype(jnp.float32)).astype(x.dtype)


def swiglu(x, wg, wu, wd):
    return (jax.nn.silu(x @ wg) * (x @ wu)) @ wd


def _lin_combine(e1, e2):
    a1, b1 = e1
    a2, b2 = e2
    return a1 * a2, a2 * b1 + b2


def s5_mixer(u, h0_re, h0_im, A_re, A_im, log_dt, B_re, B_im, C_re, C_im, d_skip, w_glu):
    n, L, _ = u.shape
    f32 = jnp.float32
    A = lax.complex(A_re.astype(f32), A_im.astype(f32))
    dt = jnp.exp(log_dt.astype(f32))[:, None]
    Abar = jnp.exp(A * dt)
    Bbar = ((Abar - 1.0) / A)[:, :, None] * lax.complex(B_re.astype(f32), B_im.astype(f32))
    ug = u.astype(f32).reshape(n, L, S5_GROUPS, S5_GROUP)
    Bu = jnp.einsum('nlgh,gph->nlgp', ug.astype(jnp.complex64), Bbar)
    h0 = lax.complex(h0_re.astype(f32), h0_im.astype(f32))[:, None]
    b = jnp.concatenate([h0, Bu], axis=1)
    a = jnp.broadcast_to(Abar, b.shape)
    _, hs = lax.associative_scan(_lin_combine, (a, b), axis=1)
    hs = hs[:, 1:]
    Cc = lax.complex(C_re.astype(f32), C_im.astype(f32))
    y = jnp.real(jnp.einsum('nlgp,ghp->nlgh', hs, Cc)) + d_skip.astype(f32).reshape(S5_GROUPS, S5_GROUP) * ug
    y = jax.nn.gelu(y.reshape(n, L, S5_WIDTH)).astype(u.dtype)
    y = y * jax.nn.sigmoid(y @ w_glu)
    h_last = hs[:, -1]
    return y, jnp.real(h_last).astype(h0_re.dtype), jnp.imag(h_last).astype(h0_re.dtype)


def causal_conv(x, buf, w, bias):
    L = x.shape[1]
    xp = jnp.concatenate([buf.astype(x.dtype), x], axis=1)
    out = sum(xp[:, j:j + L] * w[j] for j in range(CONV_W)) + bias
    return jax.nn.silu(out), xp[:, -(CONV_W - 1):]


def mlstm_chunk(carry, xs):
    C0, n0, m0 = carry
    q, k, v, ig, lf = xs
    L = q.shape[1]
    b = jnp.cumsum(lf, axis=1).transpose(0, 2, 1)
    i_ = ig.transpose(0, 2, 1)
    causal = jnp.tril(jnp.ones((L, L), dtype=bool))
    logw = jnp.where(causal, b[..., :, None] - b[..., None, :] + i_[..., None, :], -jnp.inf)
    g = b + m0[..., None]
    m = jnp.maximum(g, jnp.max(logw, axis=-1))
    w = jnp.exp(logw - m[..., None])
    inter = jnp.exp(g - m)
    s = jnp.einsum('nlhk,nshk->nhls', q, k) * w
    num = jnp.einsum('nhls,nshv->nlhv', s, v) + inter.transpose(0, 2, 1)[..., None] * jnp.einsum('nhvk,nlhk->nlhv', C0, q)
    den = jnp.sum(s, axis=-1) + inter * jnp.einsum('nhk,nlhk->nhl', n0, q)
    denom = jnp.maximum(jnp.abs(den), jnp.exp(-m))
    h = num / denom.transpose(0, 2, 1)[..., None]
    bL = b[..., -1]
    m_new = m[..., -1]
    decay = jnp.exp(bL + m0 - m_new)
    w_end = jnp.exp(bL[..., None] - b + i_ - m_new[..., None])
    C = decay[..., None, None] * C0 + jnp.einsum('nhs,nshv,nshk->nhvk', w_end, v, k)
    n = decay[..., None] * n0 + jnp.einsum('nhs,nshk->nhk', w_end, k)
    return (C, n, m_new), h


def mlstm_run(q, k, v, ig, lf, carry, lead):
    N, L = q.shape[0], q.shape[1]
    xs_all = (q, k, v, ig, lf)
    outs = []
    if lead > 0:
        carry, hl = mlstm_chunk(carry, tuple(t[:, :lead] for t in xs_all))
        outs.append(hl)
    nf, rem = divmod(L - lead, CHUNK)
    if nf > 0:
        def to_chunks(t):
            t = t[:, lead:lead + nf * CHUNK]
            return jnp.moveaxis(t.reshape((N, nf, CHUNK) + t.shape[2:]), 1, 0)
        carry, hc = lax.scan(mlstm_chunk, carry, tuple(to_chunks(t) for t in xs_all))
        hc = jnp.moveaxis(hc, 0, 1)
        outs.append(hc.reshape((N, nf * CHUNK) + hc.shape[3:]))
    if rem > 0:
        carry, ht = mlstm_chunk(carry, tuple(t[:, L - rem:] for t in xs_all))
        outs.append(ht)
    return jnp.concatenate(outs, axis=1), carry


def mlstm_mixer(qk_pre, v_pre, o_pre, i_pre, f_pre, conv_buf, C0, n0, m0, conv_w, conv_b, b_i, b_f, norm_g, lead):
    N, L, _ = qk_pre.shape
    f32 = jnp.float32
    qk, new_buf = causal_conv(qk_pre, conv_buf, conv_w, conv_b)
    q = qk[..., :QK_WIDTH // 2].reshape(N, L, MLSTM_HEADS, MLSTM_DQK).astype(f32) * (MLSTM_DQK ** -0.5)
    k = qk[..., QK_WIDTH // 2:].reshape(N, L, MLSTM_HEADS, MLSTM_DQK).astype(f32)
    v = v_pre.reshape(N, L, MLSTM_HEADS, MLSTM_DV).astype(f32)
    ig = (i_pre + b_i).astype(f32)
    lf = jax.nn.log_sigmoid((f_pre + b_f).astype(f32))
    carry = (C0.astype(f32), n0.astype(f32), m0.astype(f32))
    h, (C, n, m) = mlstm_run(q, k, v, ig, lf, carry, lead)
    h = h * lax.rsqrt(jnp.mean(h * h, axis=-1, keepdims=True) + EPS)
    h = h.reshape(N, L, V_WIDTH) * norm_g.astype(f32)
    h = (h * jax.nn.sigmoid(o_pre.astype(f32))).astype(qk_pre.dtype)
    dt = C0.dtype
    return h, C.astype(dt), n.astype(dt), m.astype(dt), new_buf.astype(conv_buf.dtype)


def layer(h, st, p, lead):
    s5_re, s5_im, C0, n0, m0, buf = st
    h = h + 0.5 * swiglu(rmsnorm(h, p['ffn1_norm']), p['ffn1_w_gate'], p['ffn1_w_up'], p['ffn1_w_down'])
    u = rmsnorm(h, p['mix_norm'])
    z = u @ p['w_in']
    o0 = S5_WIDTH
    o1 = o0 + QK_WIDTH
    o2 = o1 + V_WIDTH
    o3 = o2 + V_WIDTH
    o4 = o3 + MLSTM_HEADS
    o5 = o4 + MLSTM_HEADS
    y_s5, ns_re, ns_im = s5_mixer(z[..., :o0], s5_re, s5_im, p['s5_A_re'], p['s5_A_im'], p['s5_log_dt'],
                                  p['s5_B_re'], p['s5_B_im'], p['s5_C_re'], p['s5_C_im'], p['s5_D'], p['s5_w_glu'])
    y_ml, nC, nn_, nm, nbuf = mlstm_mixer(z[..., o0:o1], z[..., o1:o2], z[..., o2:o3], z[..., o3:o4], z[..., o4:o5],
                                          buf, C0, n0, m0, p['mlstm_conv_w'], p['mlstm_conv_b'],
                                          p['mlstm_b_i'], p['mlstm_b_f'], p['mlstm_norm'], lead)
    gates = jax.nn.sigmoid(z[..., o5:])
    merged = gates[..., :D_MODEL] * (y_s5 @ p['w_branch_s5']) + gates[..., D_MODEL:] * (y_ml @ p['w_branch_mlstm'])
    h = h + merged @ p['w_out']
    h = h + 0.5 * swiglu(rmsnorm(h, p['ffn2_norm']), p['ffn2_w_gate'], p['ffn2_w_up'], p['ffn2_w_down'])
    return h, (ns_re, ns_im, nC, nn_, nm, nbuf)


def setup_inputs(seed: int = 0) -> dict:
    key = jax.random.key(seed)
    ks = iter(jax.random.split(key, 64))

    def nrm(shape, scale=1.0):
        return jax.random.normal(next(ks), shape, jnp.float32) * scale

    def gain(shape):
        return 1.0 + nrm(shape, 0.02)

    Ld = DEPTH
    G, P, Hc = S5_GROUPS, S5_STATE, S5_GROUP
    out = {}
    out['x_prompt'] = nrm((BATCH, SEQ, D_MODEL))
    out['x_sample'] = nrm((DEC_BATCH, DEC_SEQ, D_MODEL))
    out['state_s5_re'] = nrm((Ld, DEC_BATCH, G, P), 0.1)
    out['state_s5_im'] = nrm((Ld, DEC_BATCH, G, P), 0.1)
    out['state_mlstm_C'] = nrm((Ld, DEC_BATCH, MLSTM_HEADS, MLSTM_DV, MLSTM_DQK), 0.1)
    out['state_mlstm_n'] = jnp.abs(nrm((Ld, DEC_BATCH, MLSTM_HEADS, MLSTM_DQK), 0.1))
    out['state_mlstm_m'] = nrm((Ld, DEC_BATCH, MLSTM_HEADS), 0.5)
    out['state_mlstm_conv'] = nrm((Ld, DEC_BATCH, CONV_W - 1, QK_WIDTH))
    out['meta_tokens'] = nrm((N_META, D_MODEL))
    out['ffn1_norm'] = gain((Ld, D_MODEL))
    out['ffn1_w_gate'] = nrm((Ld, D_MODEL, D_FF), D_MODEL ** -0.5)
    out['ffn1_w_up'] = nrm((Ld, D_MODEL, D_FF), D_MODEL ** -0.5)
    out['ffn1_w_down'] = nrm((Ld, D_FF, D_MODEL), D_FF ** -0.5)
    out['mix_norm'] = gain((Ld, D_MODEL))
    out['w_in'] = nrm((Ld, D_MODEL, IN_WIDTH), D_MODEL ** -0.5)
    out['s5_A_re'] = -0.5 + nrm((Ld, G, P), 0.01)
    out['s5_A_im'] = jnp.pi * jnp.arange(P, dtype=jnp.float32) + nrm((Ld, G, P), 0.01)
    out['s5_log_dt'] = jax.random.uniform(next(ks), (Ld, G), jnp.float32, math.log(DT_MIN), math.log(DT_MAX))
    out['s5_B_re'] = nrm((Ld, G, P, Hc), (2 * Hc) ** -0.5)
    out['s5_B_im'] = nrm((Ld, G, P, Hc), (2 * Hc) ** -0.5)
    out['s5_C_re'] = nrm((Ld, G, Hc, P), P ** -0.5)
    out['s5_C_im'] = nrm((Ld, G, Hc, P), P ** -0.5)
    out['s5_D'] = nrm((Ld, S5_WIDTH))
    out['s5_w_glu'] = nrm((Ld, S5_WIDTH, S5_WIDTH), S5_WIDTH ** -0.5)
    out['mlstm_conv_w'] = nrm((Ld, CONV_W, QK_WIDTH), CONV_W ** -0.5)
    out['mlstm_conv_b'] = nrm((Ld, QK_WIDTH), 0.01)
    out['mlstm_b_i'] = nrm((Ld, MLSTM_HEADS), 0.1)
    out['mlstm_b_f'] = jnp.linspace(3.0, 6.0, MLSTM_HEADS, dtype=jnp.float32) + nrm((Ld, MLSTM_HEADS), 0.1)
    out['mlstm_norm'] = gain((Ld, V_WIDTH))
    out['w_branch_s5'] = nrm((Ld, S5_WIDTH, D_MODEL), S5_WIDTH ** -0.5)
    out['w_branch_mlstm'] = nrm((Ld, V_WIDTH, D_MODEL), V_WIDTH ** -0.5)
    out['w_out'] = nrm((Ld, D_MODEL, D_MODEL), D_MODEL ** -0.5)
    out['ffn2_norm'] = gain((Ld, D_MODEL))
    out['ffn2_w_gate'] = nrm((Ld, D_MODEL, D_FF), D_MODEL ** -0.5)
    out['ffn2_w_up'] = nrm((Ld, D_MODEL, D_FF), D_MODEL ** -0.5)
    out['ffn2_w_down'] = nrm((Ld, D_FF, D_MODEL), D_FF ** -0.5)
    out['final_norm'] = gain((D_MODEL,))
    return out


def reference(x_prompt, x_sample, state_s5_re, state_s5_im, state_mlstm_C, state_mlstm_n, state_mlstm_m,
              state_mlstm_conv, meta_tokens, ffn1_norm, ffn1_w_gate, ffn1_w_up, ffn1_w_down, mix_norm, w_in,
              s5_A_re, s5_A_im, s5_log_dt, s5_B_re, s5_B_im, s5_C_re, s5_C_im, s5_D, s5_w_glu,
              mlstm_conv_w, mlstm_conv_b, mlstm_b_i, mlstm_b_f, mlstm_norm, w_branch_s5, w_branch_mlstm,
              w_out, ffn2_norm, ffn2_w_gate, ffn2_w_up, ffn2_w_down, final_norm):
    nb = x_prompt.shape[0]
    meta = jnp.broadcast_to(meta_tokens.astype(x_prompt.dtype)[None], (nb, N_META, D_MODEL))
    hp = jnp.concatenate([meta, x_prompt], axis=1)
    hs = x_sample
    sdt = state_mlstm_C.dtype
    zero_state = (jnp.zeros((nb, S5_GROUPS, S5_STATE), state_s5_re.dtype),
                  jnp.zeros((nb, S5_GROUPS, S5_STATE), state_s5_im.dtype),
                  jnp.zeros((nb, MLSTM_HEADS, MLSTM_DV, MLSTM_DQK), sdt),
                  jnp.zeros((nb, MLSTM_HEADS, MLSTM_DQK), sdt),
                  jnp.zeros((nb, MLSTM_HEADS), sdt),
                  jnp.zeros((nb, CONV_W - 1, QK_WIDTH), state_mlstm_conv.dtype))
    p_states = []
    s_states = []
    for l in range(DEPTH):
        p = {'ffn1_norm': ffn1_norm[l], 'ffn1_w_gate': ffn1_w_gate[l], 'ffn1_w_up': ffn1_w_up[l],
             'ffn1_w_down': ffn1_w_down[l], 'mix_norm': mix_norm[l], 'w_in': w_in[l],
             's5_A_re': s5_A_re[l], 's5_A_im': s5_A_im[l], 's5_log_dt': s5_log_dt[l],
             's5_B_re': s5_B_re[l], 's5_B_im': s5_B_im[l], 's5_C_re': s5_C_re[l], 's5_C_im': s5_C_im[l],
             's5_D': s5_D[l], 's5_w_glu': s5_w_glu[l], 'mlstm_conv_w': mlstm_conv_w[l],
             'mlstm_conv_b': mlstm_conv_b[l], 'mlstm_b_i': mlstm_b_i[l], 'mlstm_b_f': mlstm_b_f[l],
             'mlstm_norm': mlstm_norm[l], 'w_branch_s5': w_branch_s5[l], 'w_branch_mlstm': w_branch_mlstm[l],
             'w_out': w_out[l], 'ffn2_norm': ffn2_norm[l], 'ffn2_w_gate': ffn2_w_gate[l],
             'ffn2_w_up': ffn2_w_up[l], 'ffn2_w_down': ffn2_w_down[l]}
        hp, stp = layer(hp, zero_state, p, N_META)
        st_in = (state_s5_re[l], state_s5_im[l], state_mlstm_C[l], state_mlstm_n[l], state_mlstm_m[l],
                 state_mlstm_conv[l])
        hs, sts = layer(hs, st_in, p, 0)
        p_states.append(stp)
        s_states.append(sts)
    y_prompt = rmsnorm(hp, final_norm)[:, N_META:]
    y_sample = rmsnorm(hs, final_norm)
    p_s5_re = jnp.stack([s[0] for s in p_states])
    p_s5_im = jnp.stack([s[1] for s in p_states])
    p_C = jnp.stack([s[2] for s in p_states])
    p_n = jnp.stack([s[3] for s in p_states])
    p_m = jnp.stack([s[4] for s in p_states])
    p_conv = jnp.stack([s[5] for s in p_states])
    s_s5_re = jnp.stack([s[0] for s in s_states])
    s_s5_im = jnp.stack([s[1] for s in s_states])
    s_C = jnp.stack([s[2] for s in s_states])
    s_n = jnp.stack([s[3] for s in s_states])
    s_m = jnp.stack([s[4] for s in s_states])
    s_conv = jnp.stack([s[5] for s in s_states])
    return (y_prompt, y_sample, p_s5_re, p_s5_im, p_C, p_n, p_m, p_conv,
            s_s5_re, s_s5_im, s_C, s_n, s_m, s_conv)
```

```cpp
#include <hip/hip_runtime.h>
#include <hip/hip_cooperative_groups.h>
#include <cstdio>
#include <cstdint>
namespace cg = cooperative_groups;

#define LAS __attribute__((address_space(3)))
typedef unsigned short bf16_t;
typedef short bf16x8 __attribute__((ext_vector_type(8)));
typedef float f32x2 __attribute__((ext_vector_type(2)));
typedef float f32x4 __attribute__((ext_vector_type(4)));
typedef float f32x16 __attribute__((ext_vector_type(16)));
typedef unsigned u32x4 __attribute__((ext_vector_type(4)));
typedef unsigned u32x2 __attribute__((ext_vector_type(2)));
#define DI __device__ __forceinline__
#define LDS_WAIT() asm volatile("s_waitcnt lgkmcnt(0)" ::: "memory")

constexpr int D = 2048, DFF = 5632, NB = 4, LP = 2064, NS = 128, LS = 8;
constexpr int PROWS = NB * LP;
constexpr int NTOK = PROWS + NS * LS;
constexpr int MR = 9472;
constexpr int NIN = 8448;
constexpr int NCH = 33;
constexpr int NITEM = NB * NCH * 4;
constexpr float EPS = 1e-6f;

constexpr size_t AL(size_t x) { return (x + 255) & ~(size_t)255; }
constexpr size_t WS_SSQ = 0;
constexpr size_t WS_BAR = AL(WS_SSQ + 3 * MR * 4);
constexpr size_t WS_CNT = AL(WS_BAR + 16384);
constexpr size_t WS_ZIF = AL(WS_CNT + 4 * 256);
constexpr size_t WS_GB = AL(WS_ZIF + MR * 8 * 4);
constexpr size_t WS_GI = AL(WS_GB + MR * 4 * 4);
constexpr size_t WS_ITS = AL(WS_GI + MR * 4 * 4);
constexpr size_t WS_DN = AL(WS_ITS + 3 * NITEM * 4);
constexpr size_t WS_NJ = AL(WS_DN + NITEM * 128 * 4);
constexpr size_t WS_A8 = AL(WS_NJ + NITEM * 128 * 4);
constexpr size_t WS_S5M = AL(WS_A8 + 64 * 64 * 2 * 4);
constexpr size_t WFF_BYTES = (size_t)2 * DFF * D * 2 + (size_t)D * DFF * 2;
constexpr size_t WS_WFF = AL(WS_S5M + (size_t)64 * 3 * 16384 * 2);
constexpr size_t WS_WIN = AL(WS_WFF + WFF_BYTES);
constexpr size_t WS_WGLU = AL(WS_WIN + (size_t)NIN * D * 2);
constexpr size_t WS_WBS = AL(WS_WGLU + (size_t)1024 * 1024 * 2);
constexpr size_t WS_WBM = AL(WS_WBS + (size_t)2048 * 1024 * 2);
constexpr size_t WS_WOUT = AL(WS_WBM + (size_t)2048 * 1024 * 2);
constexpr size_t WS_XA = AL(WS_WOUT + (size_t)2048 * 2048 * 2);
constexpr size_t WS_HID = AL(WS_XA + (size_t)MR * D * 2);
constexpr size_t WS_H = AL(WS_HID + (size_t)MR * DFF * 2);
constexpr size_t WS_US5 = AL(WS_H + (size_t)MR * D * 4);
constexpr size_t WS_QKPRE = AL(WS_US5 + (size_t)MR * 1024 * 4);
constexpr size_t WS_SIGO = AL(WS_QKPRE + (size_t)MR * 1024 * 4);
constexpr size_t WS_QK = AL(WS_SIGO + (size_t)MR * 1024 * 2);
constexpr size_t WS_YS5P = AL(WS_QK + (size_t)MR * 1024 * 2);
constexpr size_t WS_END = AL(WS_YS5P + (size_t)MR * 1024 * 2);
static_assert((size_t)NITEM * 32768 * 4 <= WFF_BYTES, "DC overlay");
static_assert((size_t)NITEM * 32768 * 2 <= (size_t)MR * D * 2, "CJ overlay");

constexpr size_t O_YP = 0, O_YS = O_YP + (size_t)NB * 2048 * 2048, O_PS5R = O_YS + (size_t)NS * LS * 2048, O_PS5I = O_PS5R + NB * 4096,
                 O_PC = O_PS5I + NB * 4096, O_PN = O_PC + (size_t)NB * 4 * 32768, O_PM = O_PN + NB * 4 * 128, O_PCONV = O_PM + NB * 4,
                 O_SS5R = O_PCONV + NB * 3 * 1024, O_SS5I = O_SS5R + (size_t)NS * 4096, O_SC = O_SS5I + (size_t)NS * 4096,
                 O_SN = O_SC + (size_t)NS * 4 * 32768, O_SM = O_SN + NS * 4 * 128, O_SCONV = O_SM + NS * 4, O_END = O_SCONV + NS * 3 * 1024;

constexpr int LDS_BYTES = 288 * 512 + 1024;

DI unsigned pk2(float lo, float hi) {
    typedef __bf16 bf2 __attribute__((ext_vector_type(2)));
    f32x2 v = {lo, hi}; bf2 b = __builtin_convertvector(v, bf2); return __builtin_bit_cast(unsigned, b);
}
DI bf16x8 cvt_frag(f32x4 a, f32x4 b) { u32x4 w; w.x = pk2(a.x, a.y); w.y = pk2(a.z, a.w); w.z = pk2(b.x, b.y); w.w = pk2(b.z, b.w); return __builtin_bit_cast(bf16x8, w); }
DI float bflo(unsigned w) { return __uint_as_float(w << 16); }
DI float bfhi(unsigned w) { return __uint_as_float(w & 0xffff0000u); }
DI float bf1(bf16_t v) { return __uint_as_float(((unsigned)v) << 16); }
DI bf16_t f2bf(float f) { return (bf16_t)(pk2(f, 0.f) & 0xffffu); }
DI float sigmoidf_(float x) { return __builtin_amdgcn_rcpf(1.0f + __expf(-x)); }
DI float siluf_(float x) { return x * sigmoidf_(x); }
DI float gelu_tanh(float x) { const float u = 0.7978845608028654f * (x + 0.044715f * x * x * x); return x * sigmoidf_(2.0f * u); }
DI int crow(int reg, int h) { return (reg & 3) + 8 * (reg >> 2) + 4 * h; }
#define MFMA32(a, b, c) __builtin_amdgcn_mfma_f32_32x32x16_bf16((a), (b), (c), 0, 0, 0)
DI f32x16 zero16() { f32x16 z; for (int i = 0; i < 16; ++i) z[i] = 0.f; return z; }
DI float wave_max(float v) { for (int o = 1; o < 64; o <<= 1) v = fmaxf(v, __shfl_xor(v, o)); return v; }
DI float wave_sum(float v) { for (int o = 1; o < 64; o <<= 1) v += __shfl_xor(v, o); return v; }

namespace pg8 {
constexpr int BM = 256, BK = 64, HALF = 128, HTB = HALF * BK * 2, STAGE_BYTES = 8 * HTB, NXCD = 8, WGM = 8;
DI int lds_byte(int r, int c) { const int st = (r >> 4) * 2 + (c >> 5), rr = r & 15, cc = c & 31, ob = rr * 64 + cc * 2; return st * 1024 + (ob ^ (((ob >> 9) & 1) << 5)); }
DI void stage_rc(int b, int& R, int& C) { const int st = b / 1024, sb = b % 1024, swz = sb ^ (((sb >> 9) & 1) << 5); R = (st >> 1) * 16 + swz / 64; C = (st & 1) * 32 + (swz % 64) / 2; }
DI int perm32(int rho) { const int n = rho >> 4, i = rho & 15; return 8 * (i >> 2) + 4 * n + (i & 3); }
struct Unit { int pm, pn, sub, mask; };
struct Gemm { const bf16_t* A0; const bf16_t* A1; const bf16_t* B0; const bf16_t* B1; int K; };
struct Order {
    int nM, nN, nwg, G, c, nsub, full, R, parts, rev;
    DI void init(int M, int N, int G_, int c_, int nsub_, int maxparts, int rev_ = 0) { nM = M / BM; nN = N / BM; nwg = nM * nN; G = G_; c = c_; nsub = nsub_; rev = rev_;
        full = nwg / G; R = nwg - full * G; parts = (R > 0 && 4 * R <= G && maxparts >= 4) ? 4 : ((R > 0 && 2 * R <= G && maxparts >= 2) ? 2 : 1); }
    DI void tile(int wgid, Unit& u) const {
        if (rev) wgid = nwg - 1 - wgid;
        { const int q = nwg / NXCD, r = nwg % NXCD, xcd = wgid % NXCD, off = wgid / NXCD; wgid = (xcd < r ? xcd * (q + 1) : r * (q + 1) + (xcd - r) * q) + off; }
        const int nig = WGM * nN, gid = wgid / nig, fm = gid * WGM, gsz = (nM - fm) < WGM ? (nM - fm) : WGM;
        u.pm = fm + ((wgid % nig) % gsz); u.pn = (wgid % nig) / gsz; }
    DI bool next(int i, Unit& u) const {
        const int ti = i / nsub; u.sub = i - ti * nsub; u.mask = 15;
        if (ti < full || parts < 2) { const long L = (long)ti * G + c; if (L >= nwg) return false; tile((int)L, u); return true; }
        if (ti > full || c >= R * parts) return false;
        const int j = c / parts, part = c - j * parts; tile(full * G + j, u);
        u.mask = parts == 4 ? (1 << part) : (part ? 12 : 3); return true;
    }
};
template <class Epi>
DI void gemm_phase(LAS unsigned char* lds, const Gemm g, const Order S, const Epi E) {
    const int tid = threadIdx.x, wid = __builtin_amdgcn_readfirstlane(tid >> 6), lane = tid & 63, wr = wid >> 2, wc = wid & 3, fr = lane & 15, fq = lane >> 4;
    const int K = g.K, nt = K / BK;
    unsigned voffA[2], voffB[2];
#pragma unroll
    for (int i = 0; i < 2; ++i) { int R, C; stage_rc(tid * 16 + i * 8192, R, C); const int Rb = (R & ~31) + perm32(R & 31);
        voffA[i] = (unsigned)(R * K + C) * 2u; voffB[i] = (unsigned)(Rb * K + C) * 2u; }
    const size_t kstep = (size_t)(BK * 2);
    const size_t hstep = (size_t)HALF * K * 2;
    const size_t tstep = 2 * hstep;
    const unsigned ldsw = (unsigned)wid * 1024u;
    const int aoff = lds_byte(wr * 64 + fr, fq * 8), boff = lds_byte(wc * 32 + fr, fq * 8);
#define PG8_SA(b, h) (((b) * 2 + (h)) * HTB)
#define PG8_SB(b, h) ((4 + (b) * 2 + (h)) * HTB)
#define PG8_STAGE(bufoff, gbase, voff) do { _Pragma("unroll") for (int _i = 0; _i < 2; ++_i) \
        __builtin_amdgcn_global_load_lds((const unsigned*)((const char*)(gbase) + (voff)[_i]), (LAS unsigned*)(lds + (bufoff) + ldsw + _i * 8192), 16, 0, 0); } while (0)
#define PG8_STAGEM(need, bufoff, gbase, voff) do { const bool _n = (need); const char* _b = _n ? (const char*)(gbase) : (const char*)g.A0; _Pragma("unroll") for (int _i = 0; _i < 2; ++_i) \
        __builtin_amdgcn_global_load_lds((const unsigned*)(_b + (_n ? (voff)[_i] : 0u)), (LAS unsigned*)(lds + (bufoff) + ldsw + _i * 8192), 16, 0, 0); } while (0)
#define PG8_LDA(dst, b, h) do { _Pragma("unroll") for (int m = 0; m < 4; ++m) _Pragma("unroll") for (int k = 0; k < 2; ++k) dst[m][k] = *(const LAS bf16x8*)(lds + PG8_SA(b, h) + aoff + m * 2048 + k * 1024); } while (0)
#define PG8_LDB(dst, b, h) do { _Pragma("unroll") for (int n = 0; n < 2; ++n) _Pragma("unroll") for (int k = 0; k < 2; ++k) dst[n][k] = *(const LAS bf16x8*)(lds + PG8_SB(b, h) + boff + n * 2048 + k * 1024); } while (0)
#define PG8_MMA(ai, bj, At, Bt) do { __builtin_amdgcn_s_setprio(1); _Pragma("unroll") for (int m = 0; m < 4; ++m) _Pragma("unroll") for (int n = 0; n < 2; ++n) _Pragma("unroll") for (int k = 0; k < 2; ++k) \
        acc[ai][bj][m][n] = __builtin_amdgcn_mfma_f32_16x16x32_bf16(Bt[n][k], At[m][k], acc[ai][bj][m][n], 0, 0, 0); __builtin_amdgcn_s_setprio(0); } while (0)
#define PG8_WAIT_V(n) asm volatile("s_waitcnt vmcnt(" #n ")" ::: "memory")
#define PG8_WAIT_L(n) asm volatile("s_waitcnt lgkmcnt(" #n ")" ::: "memory")
#define PG8_BAR __builtin_amdgcn_s_barrier()
#define PG8_SCHED __builtin_amdgcn_sched_barrier(0)
    Unit cur, nxt; int ui = 0;
    if (!S.next(0, cur)) return;
    f32x4 acc[2][2][4][2];
#pragma unroll
    for (int a = 0; a < 2; ++a)
#pragma unroll
        for (int b = 0; b < 2; ++b)
#pragma unroll
            for (int m = 0; m < 4; ++m)
#pragma unroll
                for (int n = 0; n < 2; ++n) acc[a][b][m][n] = (f32x4){0.f, 0.f, 0.f, 0.f};
    bf16x8 At[4][2], B0[2][2], B1[2][2];
    const char* cA = (const char*)(cur.sub ? g.A1 : g.A0) + (size_t)cur.pm * tstep; const char* cB = (const char*)(cur.sub ? g.B1 : g.B0) + (size_t)cur.pn * tstep;
    PG8_STAGE(PG8_SB(0, 0), cB, voffB); PG8_STAGE(PG8_SB(0, 1), cB + hstep, voffB); PG8_STAGE(PG8_SA(0, 0), cA, voffA); PG8_STAGE(PG8_SA(0, 1), cA + hstep, voffA);
    if (wr == 1) PG8_BAR;
    PG8_WAIT_V(2); PG8_BAR;
    PG8_STAGE(PG8_SB(1, 0), cB + kstep, voffB); PG8_STAGE(PG8_SA(1, 0), cA + kstep, voffA); PG8_STAGE(PG8_SB(1, 1), cB + hstep + kstep, voffB);
    PG8_WAIT_V(6); PG8_BAR;
    for (;;) {
        const bool has_next = S.next(ui + 1, nxt);
        const char* nA = has_next ? (const char*)(nxt.sub ? g.A1 : g.A0) + (size_t)nxt.pm * tstep : cA; const char* nB = has_next ? (const char*)(nxt.sub ? g.B1 : g.B0) + (size_t)nxt.pn * tstep : cB;
        const int mk = cur.mask;
        for (int t = 0; t < nt; t += 2) {
            const bool last = (t == nt - 2);
            const char* a1 = cA + (size_t)(t + 1) * kstep;
            const char* a2 = last ? nA : cA + (size_t)(t + 2) * kstep; const char* b2 = last ? nB : cB + (size_t)(t + 2) * kstep;
            const char* a3 = a2 + kstep; const char* b3 = b2 + kstep;
            const int mn = (last && has_next) ? nxt.mask : mk;
            PG8_LDB(B0, 0, 0); PG8_LDB(B1, 0, 1); PG8_SCHED; PG8_LDA(At, 0, 0); PG8_STAGEM(mk & 12, PG8_SA(1, 1), a1 + hstep, voffA);
            PG8_WAIT_V(8); PG8_WAIT_L(0); PG8_BAR; if (mk & 1) PG8_MMA(0, 0, At, B0); if (mk & 2) PG8_MMA(0, 1, At, B1); PG8_BAR; PG8_SCHED;
            PG8_LDA(At, 0, 1); PG8_STAGEM(mn & 5, PG8_SB(0, 0), b2, voffB); PG8_STAGEM(mn & 10, PG8_SB(0, 1), b2 + hstep, voffB); PG8_STAGEM(mn & 3, PG8_SA(0, 0), a2, voffA);
            PG8_WAIT_V(8); PG8_WAIT_L(0); PG8_BAR; if (mk & 4) PG8_MMA(1, 0, At, B0); if (mk & 8) PG8_MMA(1, 1, At, B1); PG8_BAR; PG8_SCHED;
            PG8_LDB(B0, 1, 0); PG8_LDB(B1, 1, 1); PG8_SCHED; PG8_LDA(At, 1, 0); PG8_STAGEM(mn & 12, PG8_SA(0, 1), a2 + hstep, voffA);
            PG8_WAIT_V(8); PG8_WAIT_L(0); PG8_BAR; if (mk & 1) PG8_MMA(0, 0, At, B0); if (mk & 2) PG8_MMA(0, 1, At, B1); PG8_BAR; PG8_SCHED;
            PG8_LDA(At, 1, 1); PG8_STAGEM(mn & 5, PG8_SB(1, 0), b3, voffB); PG8_STAGEM(mn & 10, PG8_SB(1, 1), b3 + hstep, voffB); PG8_STAGEM(mn & 3, PG8_SA(1, 0), a3, voffA);
            PG8_WAIT_V(8); PG8_WAIT_L(0); PG8_BAR; if (mk & 4) PG8_MMA(1, 0, At, B0); if (mk & 8) PG8_MMA(1, 1, At, B1); PG8_BAR; PG8_SCHED;
        }
        if (wr == 0) PG8_BAR;
        E(acc, cur, wr, wc, fr, fq);
        if (!has_next) break;
#pragma unroll
        for (int a = 0; a < 2; ++a)
#pragma unroll
            for (int b = 0; b < 2; ++b)
#pragma unroll
                for (int m = 0; m < 4; ++m)
#pragma unroll
                    for (int n = 0; n < 2; ++n) acc[a][b][m][n] = (f32x4){0.f, 0.f, 0.f, 0.f};
        cur = nxt; cA = nA; cB = nB; ++ui;
        if (wr == 1) PG8_BAR;
    }
    PG8_WAIT_V(0);
    PG8_BAR;
#undef PG8_SA
#undef PG8_SB
#undef PG8_STAGE
#undef PG8_STAGEM
#undef PG8_LDA
#undef PG8_LDB
#undef PG8_MMA
#undef PG8_WAIT_V
#undef PG8_WAIT_L
#undef PG8_BAR
#undef PG8_SCHED
}
}
typedef f32x4 AccT[2][2][4][2];

struct Params {
    const float* in[37];
    float* out; unsigned char* ws;
    int ph_lo, ph_hi;
};
enum { I_XP = 0, I_XS, I_S5RE, I_S5IM, I_MC, I_MN, I_MM, I_MCONV, I_META, I_F1N, I_F1G, I_F1U, I_F1D, I_MIXN, I_WIN, I_AR, I_AI, I_LDT, I_BR, I_BI, I_CR, I_CI, I_S5D, I_WGLU,
       I_CW, I_CB, I_MBI, I_MBF, I_MNORM, I_WBS, I_WBM, I_WOUT, I_F2N, I_F2G, I_F2U, I_F2D, I_FINN };

struct Frame {
    LAS unsigned char* lds;
    const Params* P;
    unsigned char* ws;
    int tid, lane, wave, G, bid;
};
DI const float* xrow(const Params& P, int r) {
    if (r < PROWS) { const int b = r / LP, t = r - b * LP; return t < 16 ? P.in[I_META] + (size_t)t * D : P.in[I_XP] + ((size_t)b * 2048 + (t - 16)) * D; }
    if (r < NTOK) return P.in[I_XS] + (size_t)(r - PROWS) * D;
    return nullptr;
}

struct EpiSwiglu {
    bf16_t* HID; const float* ssq;
    DI void operator()(const AccT& acc, const pg8::Unit& u, int wr, int wc, int fr, int fq) const {
        const int row0 = u.pm * 256 + wr * 64 + fr, col0 = u.pn * 128 + wc * 32 + 8 * fq;
        float rsv[8];
#pragma unroll
        for (int q = 0; q < 8; ++q) rsv[q] = ssq ? ssq[row0 + (q >> 2) * 128 + (q & 3) * 16] : 0.f;
#pragma unroll
        for (int ai = 0; ai < 2; ++ai)
#pragma unroll
            for (int m = 0; m < 4; ++m) {
                if (!((u.mask >> (ai * 2)) & 1)) continue;
                const int r = row0 + ai * 128 + m * 16;
                const float rs = ssq ? rsqrtf(rsv[ai * 4 + m] * (1.0f / D) + EPS) : 1.0f;
                float h[8];
#pragma unroll
                for (int n = 0; n < 2; ++n)
#pragma unroll
                    for (int j = 0; j < 4; ++j) h[n * 4 + j] = siluf_(acc[ai][0][m][n][j] * rs) * (acc[ai][1][m][n][j] * rs);
                u32x4 w; w.x = pk2(h[0], h[1]); w.y = pk2(h[2], h[3]); w.z = pk2(h[4], h[5]); w.w = pk2(h[6], h[7]);
                *(u32x4*)(HID + (size_t)r * DFF + col0) = w;
            }
    }
};
template <int MODE> struct EpiResid {
    const Params* P;
    DI void operator()(const AccT& acc, const pg8::Unit& u, int wr, int wc, int fr, int fq) const {
        const bool from_inputs = MODE == 0; const float scale = MODE == 1 ? 1.0f : 0.5f;
        float* const H = (float*)(P->ws + WS_H); float* const ssq = (float*)(P->ws + WS_SSQ) + MODE * MR;
        const float* const gain = MODE == 0 ? P->in[I_MIXN] : (MODE == 1 ? P->in[I_F2N] : nullptr); bf16_t* const Aout = MODE < 2 ? (bf16_t*)(P->ws + WS_XA) : nullptr;
        const int row0 = u.pm * 256 + wr * 64 + fr, col0 = u.pn * 256 + wc * 32 + 8 * fq;
        f32x4 gv[2][2];
#pragma unroll
        for (int bj = 0; bj < 2; ++bj) { gv[bj][0] = (f32x4){1.f, 1.f, 1.f, 1.f}; gv[bj][1] = gv[bj][0]; if (MODE < 2) { gv[bj][0] = *(const f32x4*)(gain + col0 + bj * 128); gv[bj][1] = *(const f32x4*)(gain + col0 + bj * 128 + 4); } }
#pragma unroll
        for (int ai = 0; ai < 2; ++ai) {
            if ((u.mask >> (ai * 2)) & 3) {
            f32x4 rv[4][2][2];
#pragma unroll
            for (int m = 0; m < 4; ++m) { const int r = row0 + ai * 128 + m * 16; const float* res = from_inputs ? xrow(*P, r) : H + (size_t)r * D;
#pragma unroll
                for (int bj = 0; bj < 2; ++bj) { rv[m][bj][0] = (f32x4){0.f, 0.f, 0.f, 0.f}; rv[m][bj][1] = rv[m][bj][0];
                    if (res && ((u.mask >> (ai * 2 + bj)) & 1)) { rv[m][bj][0] = *(const f32x4*)(res + col0 + bj * 128); rv[m][bj][1] = *(const f32x4*)(res + col0 + bj * 128 + 4); } } }
#pragma unroll
            for (int m = 0; m < 4; ++m) {
                const int r = row0 + ai * 128 + m * 16;
                float ss = 0.f;
#pragma unroll
                for (int bj = 0; bj < 2; ++bj) {
                    if ((u.mask >> (ai * 2 + bj)) & 1) {
                    const int c = col0 + bj * 128;
                    const f32x4 v0 = rv[m][bj][0] + acc[ai][bj][m][0] * scale, v1 = rv[m][bj][1] + acc[ai][bj][m][1] * scale;
                    *(f32x4*)(H + (size_t)r * D + c) = v0; *(f32x4*)(H + (size_t)r * D + c + 4) = v1;
                    ss += (v0.x * v0.x + v0.y * v0.y) + (v0.z * v0.z + v0.w * v0.w) + (v1.x * v1.x + v1.y * v1.y) + (v1.z * v1.z + v1.w * v1.w);
                    if (MODE < 2) { const f32x4 g0 = gv[bj][0], g1 = gv[bj][1];
                        u32x4 w; w.x = pk2(v0.x * g0.x, v0.y * g0.y); w.y = pk2(v0.z * g0.z, v0.w * g0.w); w.z = pk2(v1.x * g1.x, v1.y * g1.y); w.w = pk2(v1.z * g1.z, v1.w * g1.w);
                        *(u32x4*)(Aout + (size_t)r * D + c) = w; }
                    }
                }
                ss += __shfl_xor(ss, 16); ss += __shfl_xor(ss, 32);
                if (fq == 0) atomicAdd(ssq + r, ss);
            } }
        }
    }
};
struct EpiWin {
    float* US5; float* QKPRE; bf16_t* V; bf16_t* SIGO; bf16_t* GATES; float* ZIF; const float* ssq;
    DI void operator()(const AccT& acc, const pg8::Unit& u, int wr, int wc, int fr, int fq) const {
        const int row0 = u.pm * 256 + wr * 64 + fr, pn = u.pn, cl = wc * 32 + 8 * fq;
        float rsv[8];
#pragma unroll
        for (int q = 0; q < 8; ++q) rsv[q] = ssq[row0 + (q >> 2) * 128 + (q & 3) * 16];
#pragma unroll
        for (int ai = 0; ai < 2; ++ai)
#pragma unroll
            for (int m = 0; m < 4; ++m) {
                const int r = row0 + ai * 128 + m * 16;
                const float rs = rsqrtf(rsv[ai * 4 + m] * (1.0f / D) + EPS);
#pragma unroll
                for (int bj = 0; bj < 2; ++bj) {
                    const int c = pn * 256 + bj * 128 + cl;
                    f32x4 v0 = acc[ai][bj][m][0] * rs, v1 = acc[ai][bj][m][1] * rs;
                    if (pn < 8) { float* dst = (pn < 4 ? US5 + (size_t)r * 1024 + c : QKPRE + (size_t)r * 1024 + (c - 1024)); *(f32x4*)dst = v0; *(f32x4*)(dst + 4) = v1; }
                    else if (pn < 32) {
                        if (pn >= 12) {
#pragma unroll
                            for (int j = 0; j < 4; ++j) { v0[j] = sigmoidf_(v0[j]); v1[j] = sigmoidf_(v1[j]); } }
                        u32x4 w; w.x = pk2(v0.x, v0.y); w.y = pk2(v0.z, v0.w); w.z = pk2(v1.x, v1.y); w.w = pk2(v1.z, v1.w);
                        bf16_t* dst = pn < 12 ? V + (size_t)r * 1024 + (c - 2048) : (pn < 16 ? SIGO + (size_t)r * 1024 + (c - 3072) : GATES + (size_t)r * 4096 + (c - 4096));
                        *(u32x4*)dst = w; }
                    else if (bj == 0 && cl == 0) { *(f32x4*)(ZIF + (size_t)r * 8) = v0; *(f32x4*)(ZIF + (size_t)r * 8 + 4) = v1; }
                }
            }
    }
};
struct EpiGlu {
    const bf16_t* YP; bf16_t* YO;
    DI void operator()(const AccT& acc, const pg8::Unit& u, int wr, int wc, int fr, int fq) const {
        const int row0 = u.pm * 256 + wr * 64 + fr, col0 = u.pn * 256 + wc * 32 + 8 * fq;
        u32x4 yv[8][2];
#pragma unroll
        for (int q = 0; q < 8; ++q)
#pragma unroll
            for (int bj = 0; bj < 2; ++bj) yv[q][bj] = *(const u32x4*)(YP + (size_t)(row0 + (q >> 2) * 128 + (q & 3) * 16) * 1024 + col0 + bj * 128);
#pragma unroll
        for (int ai = 0; ai < 2; ++ai)
#pragma unroll
            for (int m = 0; m < 4; ++m) {
                const int r = row0 + ai * 128 + m * 16;
#pragma unroll
                for (int bj = 0; bj < 2; ++bj) {
                    const size_t o = (size_t)r * 1024 + col0 + bj * 128;
                    const u32x4 y = yv[ai * 4 + m][bj]; const f32x4 a0 = acc[ai][bj][m][0], a1 = acc[ai][bj][m][1];
                    u32x4 w; w.x = pk2(bflo(y.x) * sigmoidf_(a0.x), bfhi(y.x) * sigmoidf_(a0.y)); w.y = pk2(bflo(y.y) * sigmoidf_(a0.z), bfhi(y.y) * sigmoidf_(a0.w));
                    w.z = pk2(bflo(y.z) * sigmoidf_(a1.x), bfhi(y.z) * sigmoidf_(a1.y)); w.w = pk2(bflo(y.w) * sigmoidf_(a1.z), bfhi(y.w) * sigmoidf_(a1.w));
                    *(u32x4*)(YO + o) = w; }
            }
    }
};
struct EpiBranch {
    const bf16_t* GATES; bf16_t* MG;
    DI void operator()(const AccT& acc, const pg8::Unit& u, int wr, int wc, int fr, int fq) const {
        const int row0 = u.pm * 256 + wr * 64 + fr, col0 = u.pn * 256 + wc * 32 + 8 * fq;
#pragma unroll
        for (int ai = 0; ai < 2; ++ai) {
            if ((u.mask >> (ai * 2)) & 3) {
            u32x4 gt[4][2], pv[4][2];
#pragma unroll
            for (int m = 0; m < 4; ++m)
#pragma unroll
                for (int bj = 0; bj < 2; ++bj) { const int r = row0 + ai * 128 + m * 16, c = col0 + bj * 128; gt[m][bj] = (u32x4){0u, 0u, 0u, 0u}; pv[m][bj] = gt[m][bj];
                    if ((u.mask >> (ai * 2 + bj)) & 1) { gt[m][bj] = *(const u32x4*)(GATES + (size_t)r * 4096 + u.sub * 2048 + c); if (u.sub) pv[m][bj] = *(const u32x4*)(MG + (size_t)r * D + c); } }
#pragma unroll
            for (int m = 0; m < 4; ++m) {
                const int r = row0 + ai * 128 + m * 16;
#pragma unroll
                for (int bj = 0; bj < 2; ++bj) {
                    if ((u.mask >> (ai * 2 + bj)) & 1) {
                    const int c = col0 + bj * 128;
                    const u32x4 g = gt[m][bj], p = pv[m][bj]; const f32x4 a0 = acc[ai][bj][m][0], a1 = acc[ai][bj][m][1];
                    float v[8] = {bflo(g.x) * a0.x, bfhi(g.x) * a0.y, bflo(g.y) * a0.z, bfhi(g.y) * a0.w, bflo(g.z) * a1.x, bfhi(g.z) * a1.y, bflo(g.w) * a1.z, bfhi(g.w) * a1.w};
                    if (u.sub) { v[0] += bflo(p.x); v[1] += bfhi(p.x); v[2] += bflo(p.y); v[3] += bfhi(p.y); v[4] += bflo(p.z); v[5] += bfhi(p.z); v[6] += bflo(p.w); v[7] += bfhi(p.w); }
                    u32x4 w; w.x = pk2(v[0], v[1]); w.y = pk2(v[2], v[3]); w.z = pk2(v[4], v[5]); w.w = pk2(v[6], v[7]);
                    *(u32x4*)(MG + (size_t)r * D + c) = w; } }
            } }
        }
    }
};

DI void tr_item(const float* W, int N, int srcn0, int nvalid, bf16_t* WT, int K, int dstrow0, int k0, LAS float* scr, int lane) {
    const int c4 = lane & 7, k8 = lane >> 3;
#pragma unroll
    for (int i = 0; i < 8; ++i) { const int kk = 8 * i + k8; f32x4 v = (f32x4){0.f, 0.f, 0.f, 0.f};
        if (4 * c4 < nvalid) v = __builtin_nontemporal_load((const f32x4*)(W + (size_t)(k0 + kk) * N + srcn0 + 4 * c4));
        LAS float* d = scr + kk * 33 + 4 * c4; d[0] = v.x; d[1] = v.y; d[2] = v.z; d[3] = v.w; }
    LDS_WAIT();
    const int c = lane & 7;
#pragma unroll
    for (int j = 0; j < 4; ++j) { const int n = (lane >> 3) + 8 * j; const LAS float* s = scr + (8 * c) * 33 + n;
        u32x4 o; o.x = pk2(s[0 * 33], s[1 * 33]); o.y = pk2(s[2 * 33], s[3 * 33]); o.z = pk2(s[4 * 33], s[5 * 33]); o.w = pk2(s[6 * 33], s[7 * 33]);
        *(u32x4*)(WT + (size_t)(dstrow0 + n) * K + k0 + 8 * c) = o; }
    LDS_WAIT();
}
constexpr int FFN_ITEMS_GU = 32 * 352, FFN_ITEMS_D = 88 * 64, FFN_ITEMS = FFN_ITEMS_GU + FFN_ITEMS_D;
DI void ffn_conv_item(const float* wg, const float* wu, const float* wd, bf16_t* dst, int it, LAS float* scr, int lane) {
    if (it < FFN_ITEMS_GU) { const int kb = it / 352, nb = it - kb * 352, d0 = nb * 32, tile = d0 >> 8, w = d0 & 255;
        tr_item(w < 128 ? wg : wu, DFF, tile * 128 + (w & 127), 32, dst, D, d0, kb * 64, scr, lane); }
    else { it -= FFN_ITEMS_GU; const int kb = it / 64, nb = it - kb * 64;
        tr_item(wd, D, nb * 32, 32, dst + (size_t)2 * DFF * D, DFF, nb * 32, kb * 64, scr, lane); }
}
DI void rms_row(Frame& F, int r, const float* gain, bf16_t* out) {
    const float* x = xrow(*F.P, r); u32x2* o = (u32x2*)(out + (size_t)r * D);
    if (!x) { for (int j = 0; j < 8; ++j) o[64 * j + F.lane] = (u32x2){0u, 0u}; return; }
    f32x4 v[8]; float s = 0.f;
#pragma unroll
    for (int j = 0; j < 8; ++j) { v[j] = ((const f32x4*)x)[64 * j + F.lane]; s += (v[j].x * v[j].x + v[j].y * v[j].y) + (v[j].z * v[j].z + v[j].w * v[j].w); }
    const float rs = rsqrtf(wave_sum(s) * (1.0f / D) + EPS);
#pragma unroll
    for (int j = 0; j < 8; ++j) { const f32x4 g = ((const f32x4*)gain)[64 * j + F.lane];
        o[64 * j + F.lane] = (u32x2){pk2(v[j].x * rs * g.x, v[j].y * rs * g.y), pk2(v[j].z * rs * g.z, v[j].w * rs * g.w)}; }
}
DI void s5_precompute(Frame& F, int g) {
    const Params& P = *F.P;
    LAS float* pw = (LAS float*)F.lds;
    LAS float* Bb = pw + 9 * 128;
    LAS float* Cc = Bb + 2048;
    LAS float* Kd = Cc + 2048;
    const int tid = F.tid;
    if (tid < 64) { const int p = tid;
        const float are = P.in[I_AR][g * 64 + p], aim = P.in[I_AI][g * 64 + p], dt = expf(P.in[I_LDT][g]);
        const float er = expf(are * dt), ang = aim * dt; const float ar = er * cosf(ang), ai = er * sinf(ang);
        float pr = 1.f, pi = 0.f;
        for (int d = 0; d <= 8; ++d) { pw[(d * 64 + p) * 2] = pr; pw[(d * 64 + p) * 2 + 1] = pi; const float nr = pr * ar - pi * ai, ni = pr * ai + pi * ar; pr = nr; pi = ni; }
        float* a8 = (float*)(F.ws + WS_A8) + (g * 64 + p) * 2; a8[0] = pw[(8 * 64 + p) * 2]; a8[1] = pw[(8 * 64 + p) * 2 + 1];
        const float nr = ar - 1.f, ni = ai, den = 1.0f / (are * are + aim * aim);
        const float cr = (nr * are + ni * aim) * den, ci = (ni * are - nr * aim) * den;
        for (int h = 0; h < 16; ++h) { const float br = P.in[I_BR][(g * 64 + p) * 16 + h], bi = P.in[I_BI][(g * 64 + p) * 16 + h];
            Bb[(p * 16 + h) * 2] = cr * br - ci * bi; Bb[(p * 16 + h) * 2 + 1] = cr * bi + ci * br; }
    }
    for (int e = tid; e < 1024; e += 512) { Cc[e * 2] = P.in[I_CR][g * 1024 + e]; Cc[e * 2 + 1] = P.in[I_CI][g * 1024 + e]; }
    __syncthreads();
    bf16_t* Em = (bf16_t*)(F.ws + WS_S5M) + (size_t)g * 3 * 16384; bf16_t* Mm = Em + 16384; bf16_t* Fm = Em + 32768;
    for (int e = tid; e < 2048; e += 512) { const int d = e >> 8, h = (e >> 4) & 15, h2 = e & 15; float s = 0.f;
        for (int p = 0; p < 64; ++p) { const float cr = Cc[(h * 64 + p) * 2], ci = Cc[(h * 64 + p) * 2 + 1], wr_ = pw[(d * 64 + p) * 2], wi = pw[(d * 64 + p) * 2 + 1];
            const float xr = cr * wr_ - ci * wi, xi = cr * wi + ci * wr_; s += xr * Bb[(p * 16 + h2) * 2] - xi * Bb[(p * 16 + h2) * 2 + 1]; }
        Kd[e] = s; }
    for (int e = tid; e < 16384; e += 512) { const int n = e >> 7, k = e & 127;
        { const int ri = n >> 6, p = n & 63, s = k >> 4, h2 = k & 15; const float wr_ = pw[((7 - s) * 64 + p) * 2], wi = pw[((7 - s) * 64 + p) * 2 + 1], br = Bb[(p * 16 + h2) * 2], bi = Bb[(p * 16 + h2) * 2 + 1];
          Em[e] = f2bf(ri ? wr_ * bi + wi * br : wr_ * br - wi * bi); }
        { const int t = n >> 4, h = n & 15, ri = k >> 6, p = k & 63; const float cr = Cc[(h * 64 + p) * 2], ci = Cc[(h * 64 + p) * 2 + 1], wr_ = pw[((t + 1) * 64 + p) * 2], wi = pw[((t + 1) * 64 + p) * 2 + 1];
          Fm[e] = f2bf(ri ? -(cr * wi + ci * wr_) : cr * wr_ - ci * wi); }
    }
    __syncthreads();
    for (int e = tid; e < 16384; e += 512) { const int n = e >> 7, k = e & 127, t = n >> 4, h = n & 15, s = k >> 4, h2 = k & 15;
        Mm[e] = f2bf(s <= t ? Kd[((t - s) * 16 + h) * 16 + h2] : 0.f); }
    __syncthreads();
}

DI int hsw(int r, int c) { return r * 128 + (c ^ ((r & 15) << 3)); }
constexpr int S5_UROW = 136;
DI void s5_item(Frame& F, int item) {
    const Params& P = *F.P;
    const bool samp = item >= 256; const int g = samp ? item - 256 : (item & 63), n = samp ? 0 : (item >> 6);
    const int npass = samp ? 1 : 2, prow = samp ? 128 : 129, nunits = samp ? 16 : 20, tokbase = samp ? PROWS : n * LP;
    LAS float* H = (LAS float*)F.lds;
    LAS bf16_t* U = (LAS bf16_t*)(F.lds + 160 * 512);
    const bf16_t* Em = (const bf16_t*)(F.ws + WS_S5M) + (size_t)g * 3 * 16384; const bf16_t* Mm = Em + 16384; const bf16_t* Fm = Em + 32768;
    const float* US5 = (const float*)(F.ws + WS_US5); bf16_t* YP = (bf16_t*)(F.ws + WS_YS5P);
    const int lane = F.lane, r31 = lane & 31, hh = lane >> 5;
    const float* a8p = (const float*)(F.ws + WS_A8) + (g * 64 + lane) * 2; const float ar = a8p[0], ai = a8p[1];
    float hr = 0.f, hi = 0.f;
#pragma unroll 1
    for (int pass = 0; pass < npass; ++pass) {
        const int tok0 = tokbase + pass * prow * 8;
        for (int e = F.tid; e < prow * 8 * 4; e += 512) { const int tk = e >> 2, q = e & 3; const f32x4 v = *(const f32x4*)(US5 + (size_t)(tok0 + tk) * 1024 + g * 16 + q * 4);
            *(LAS u32x2*)(U + (tk >> 3) * S5_UROW + (tk & 7) * 16 + q * 4) = (u32x2){pk2(v.x, v.y), pk2(v.z, v.w)}; }
        __syncthreads();
#pragma unroll 1
        for (int u = F.wave; u < nunits; u += 8) {
            const int rb = u >> 2, nb = u & 3, row = rb * 32 + r31; const bool valid = row < prow;
            bf16x8 bfr[8];
#pragma unroll
            for (int kb = 0; kb < 8; ++kb) bfr[kb] = *(const bf16x8*)(Em + (nb * 32 + r31) * 128 + kb * 16 + 8 * hh);
            f32x16 acc = zero16();
#pragma unroll
            for (int kb = 0; kb < 8; ++kb) { bf16x8 a = (bf16x8){0, 0, 0, 0, 0, 0, 0, 0}; if (valid) a = *(const LAS bf16x8*)(U + row * S5_UROW + kb * 16 + 8 * hh); acc = MFMA32(a, bfr[kb], acc); }
#pragma unroll
            for (int reg = 0; reg < 16; ++reg) H[hsw(rb * 32 + crow(reg, hh), nb * 32 + r31)] = acc[reg];
        }
        __syncthreads();
        if (samp) { for (int r = F.wave; r < 128; r += 8) { const size_t si = ((size_t)r * 64 + g) * 64 + lane; const float h0r = P.in[I_S5RE][si], h0i = P.in[I_S5IM][si];
                const float lr = H[hsw(r, lane)], li = H[hsw(r, 64 + lane)];
                P.out[O_SS5R + si] = ar * h0r - ai * h0i + lr; P.out[O_SS5I + si] = ar * h0i + ai * h0r + li; H[hsw(r, lane)] = h0r; H[hsw(r, 64 + lane)] = h0i; } }
        else if (F.wave == 0) {
#pragma unroll 1
            for (int j0 = 0; j0 < 136; j0 += 8) { float lr[8], li[8];
#pragma unroll
                for (int q = 0; q < 8; ++q) { const int j = j0 + q < 129 ? j0 + q : 128; lr[q] = H[hsw(j, lane)]; li[q] = H[hsw(j, 64 + lane)]; }
#pragma unroll
                for (int q = 0; q < 8; ++q) { if (j0 + q < 129) { H[hsw(j0 + q, lane)] = hr; H[hsw(j0 + q, 64 + lane)] = hi;
                    const float nr = ar * hr - ai * hi + lr[q], ni = ar * hi + ai * hr + li[q]; hr = nr; hi = ni; } } }
            if (pass == 1) { const size_t si = ((size_t)n * 64 + g) * 64 + lane; P.out[O_PS5R + si] = hr; P.out[O_PS5I + si] = hi; } }
        __syncthreads();
#pragma unroll 1
        for (int u = F.wave; u < nunits; u += 8) {
            const int rb = u >> 2, nb = u & 3, row = rb * 32 + r31; const bool valid = row < prow;
            const int col = nb * 32 + r31, t = col >> 4, ch = g * 16 + (col & 15); const float Dv = P.in[I_S5D][ch];
            bf16x8 mfr[8], ffr[8]; float uo[16];
#pragma unroll
            for (int kb = 0; kb < 8; ++kb) { mfr[kb] = *(const bf16x8*)(Mm + (nb * 32 + r31) * 128 + kb * 16 + 8 * hh); ffr[kb] = *(const bf16x8*)(Fm + (nb * 32 + r31) * 128 + kb * 16 + 8 * hh); }
#pragma unroll
            for (int reg = 0; reg < 16; ++reg) { const int rr = rb * 32 + crow(reg, hh); uo[reg] = rr < prow ? US5[(size_t)(tok0 + rr * 8 + t) * 1024 + ch] : 0.f; }
            f32x16 acc = zero16();
#pragma unroll
            for (int kb = 0; kb < 8; ++kb) { bf16x8 a = (bf16x8){0, 0, 0, 0, 0, 0, 0, 0}; if (valid) a = *(const LAS bf16x8*)(U + row * S5_UROW + kb * 16 + 8 * hh); acc = MFMA32(a, mfr[kb], acc); }
#pragma unroll
            for (int kb = 0; kb < 8; ++kb) { const LAS float* hp = H + row * 128 + (((kb * 2 + hh) ^ (row & 15)) << 3); acc = MFMA32(cvt_frag(*(const LAS f32x4*)hp, *(const LAS f32x4*)(hp + 4)), ffr[kb], acc); }
#pragma unroll
            for (int reg = 0; reg < 16; ++reg) { const int rr = rb * 32 + crow(reg, hh);
                if (rr < prow) YP[(size_t)(tok0 + rr * 8 + t) * 1024 + ch] = f2bf(gelu_tanh(acc[reg] + Dv * uo[reg])); }
        }
        __syncthreads();
    }
}

constexpr int VT_STRIDE = 72;
DI float log_sigmoid(float x) { return fminf(x, 0.f) - log1pf(expf(-fabsf(x))); }
DI float conv1(const Params& P, float xm3, float xm2, float xm1, float x0, int col) {
    const float* w = P.in[I_CW]; return siluf_(xm3 * w[col] + xm2 * w[1024 + col] + xm1 * w[2048 + col] + x0 * w[3072 + col] + P.in[I_CB][col]);
}
DI void mlstm_prep(Frame& F, int item) {
    const Params& P = *F.P;
    const int hd = item & 3, c = (item >> 2) % NCH, n = (item >> 2) / NCH;
    const int t0 = c == 0 ? 0 : 16 + 64 * (c - 1), L = c == 0 ? 16 : 64, R0 = n * LP + t0;
    LAS bf16_t* KT = (LAS bf16_t*)F.lds;
    LAS bf16_t* VT = KT + 128 * VT_STRIDE + F.wave * 32 * VT_STRIDE;
    LAS float* wsc = (LAS float*)(F.lds + (128 + 256) * VT_STRIDE * 2);
    const float* ZIF = (const float*)(F.ws + WS_ZIF); const float* QKPRE = (const float*)(F.ws + WS_QKPRE);
    bf16_t* QK = (bf16_t*)(F.ws + WS_QK); const bf16_t* V = (const bf16_t*)(F.ws + WS_HID) + (size_t)MR * 4096;
    const int lane = F.lane, tid = F.tid;
    if (F.wave == 0) { const bool valid = lane < L; const int R = R0 + lane;
        const float ig = valid ? ZIF[(size_t)R * 8 + hd] + P.in[I_MBI][hd] : 0.f;
        const float lf = valid ? log_sigmoid(ZIF[(size_t)R * 8 + 4 + hd] + P.in[I_MBF][hd]) : 0.f;
        float b = lf; for (int o = 1; o < 64; o <<= 1) { const float t = __shfl_up(b, o); if (lane >= o) b += t; }
        const float bL = __shfl(b, L - 1);
        const float a = valid ? bL - b + ig : -INFINITY; const float mloc = wave_max(a);
        wsc[lane] = valid ? __expf(a - mloc) : 0.f;
        if (valid) { ((float*)(F.ws + WS_GB))[(size_t)R * 4 + hd] = b; ((float*)(F.ws + WS_GI))[(size_t)R * 4 + hd] = ig; }
        if (lane == 0) { float* its = (float*)(F.ws + WS_ITS); its[item] = bL; its[NITEM + item] = mloc; }
    }
    __syncthreads();
    { const int ch = tid & 255, col = ch < 128 ? hd * 128 + ch : 512 + hd * 128 + (ch - 128), s0 = (tid >> 8) * 32;
      const float* cw = P.in[I_CW]; const float w0 = cw[col], w1 = cw[1024 + col], w2 = cw[2048 + col], w3 = cw[3072 + col], cb = P.in[I_CB][col];
#pragma unroll 1
      for (int sq = s0; sq < s0 + 32 && sq < L; sq += 16) {
          const float* xp = QKPRE + (size_t)(R0 + sq) * 1024 + col; bf16_t* qo = QK + (size_t)(R0 + sq) * 1024 + col;
          float x[19];
#pragma unroll
          for (int i = 0; i < 19; ++i) x[i] = (t0 + sq - 3 + i >= 0) ? xp[(i - 3) * 1024] : 0.f;
#pragma unroll
          for (int i = 0; i < 16; ++i) {
              float v = siluf_(x[i] * w0 + x[i + 1] * w1 + x[i + 2] * w2 + x[i + 3] * w3 + cb); if (ch < 128) v *= 0.08838834764831845f;
              qo[i * 1024] = f2bf(v);
              if (ch >= 128) KT[(ch - 128) * VT_STRIDE + sq + i] = f2bf(v * wsc[sq + i]); } } }
    { const bool valid = lane < L; const bf16_t* vp = V + (size_t)(R0 + lane) * 1024 + hd * 256 + F.wave * 32;
#pragma unroll
      for (int q = 0; q < 4; ++q) { u32x4 w = (u32x4){0u, 0u, 0u, 0u}; if (valid) w = *(const u32x4*)(vp + q * 8);
          const unsigned ww[4] = {w.x, w.y, w.z, w.w};
#pragma unroll
          for (int j = 0; j < 4; ++j) { VT[(q * 8 + 2 * j) * VT_STRIDE + lane] = (bf16_t)(ww[j] & 0xffffu); VT[(q * 8 + 2 * j + 1) * VT_STRIDE + lane] = (bf16_t)(ww[j] >> 16); } } }
    __syncthreads();
    { const int r31 = lane & 31, hh = lane >> 5, nks = c == 0 ? 1 : 4;
      float* DC = (float*)(F.ws + WS_WFF) + (size_t)item * 32768;
#pragma unroll 1
      for (int nb = 0; nb < 4; ++nb) { f32x16 acc = zero16();
          for (int ks = 0; ks < nks; ++ks) { const bf16x8 a = *(const LAS bf16x8*)(VT + r31 * VT_STRIDE + ks * 16 + 8 * hh), b = *(const LAS bf16x8*)(KT + (nb * 32 + r31) * VT_STRIDE + ks * 16 + 8 * hh); acc = MFMA32(a, b, acc); }
#pragma unroll
          for (int reg = 0; reg < 16; ++reg) DC[(F.wave * 32 + crow(reg, hh)) * 128 + nb * 32 + r31] = acc[reg]; }
      if (tid < 128) { float s = 0.f; for (int q = 0; q < L; ++q) s += bf1(KT[tid * VT_STRIDE + q]); ((float*)(F.ws + WS_DN))[item * 128 + tid] = s; } }
    __syncthreads();
}
DI void mlstm_scan(Frame& F) {
    const Params& P = *F.P;
    const float* its = (const float*)(F.ws + WS_ITS); float* m0s = (float*)(F.ws + WS_ITS) + 2 * NITEM;
    const float* DC = (const float*)(F.ws + WS_WFF); bf16_t* CJ = (bf16_t*)(F.ws + WS_XA);
    const int gid = F.bid * 512 + F.tid;
    if (gid < 16 * 8192) { const int chain = gid >> 13, e4 = gid & 8191, n = chain >> 2, hd = chain & 3;
        f32x4 C = (f32x4){0.f, 0.f, 0.f, 0.f}; float m0 = 0.f;
#pragma unroll 1
        for (int c0 = 0; c0 < NCH; c0 += 11) { f32x4 d[11];
#pragma unroll
            for (int j = 0; j < 11; ++j) d[j] = __builtin_nontemporal_load((const f32x4*)(DC + (size_t)((n * NCH + c0 + j) * 4 + hd) * 32768 + e4 * 4));
#pragma unroll
            for (int j = 0; j < 11; ++j) { const int item = (n * NCH + c0 + j) * 4 + hd;
                const float bL = its[item], ml = its[NITEM + item], mn = fmaxf(bL + m0, ml), dec = __expf(bL + m0 - mn), sc = __expf(ml - mn);
                *(u32x2*)(CJ + (size_t)item * 32768 + e4 * 4) = (u32x2){pk2(C.x, C.y), pk2(C.z, C.w)};
                C = C * dec + d[j] * sc; m0 = mn; } }
        *(f32x4*)(P.out + O_PC + (size_t)chain * 32768 + e4 * 4) = C; }
    if (F.bid == 255) { const int chain = F.tid >> 5, k4 = F.tid & 31, n = chain >> 2, hd = chain & 3;
        const float* DN = (const float*)(F.ws + WS_DN); float* NJ = (float*)(F.ws + WS_NJ);
        f32x4 C = (f32x4){0.f, 0.f, 0.f, 0.f}; float m0 = 0.f;
        for (int c = 0; c < NCH; ++c) { const int item = (n * NCH + c) * 4 + hd;
            const float bL = its[item], ml = its[NITEM + item], mn = fmaxf(bL + m0, ml), dec = __expf(bL + m0 - mn), sc = __expf(ml - mn);
            *(f32x4*)(NJ + item * 128 + k4 * 4) = C; if (k4 == 0) m0s[item] = m0;
            const f32x4 d = *(const f32x4*)(DN + item * 128 + k4 * 4);
            C = C * dec + d * sc; m0 = mn; }
        *(f32x4*)(P.out + O_PN + chain * 128 + k4 * 4) = C; if (k4 == 0) P.out[O_PM + chain] = m0; }
}
DI void out_xtile(const bf16x8 (&kf)[8], const bf16x8 (&qf)[8], int sb, int t, int L, float bmt, const LAS float* sm, const LAS bf16_t* VT, int r31, int hh, f32x16& acc1, float& den1) {
    f32x16 x = zero16();
#pragma unroll
    for (int ks = 0; ks < 8; ++ks) x = MFMA32(kf[ks], qf[ks], x);
#pragma unroll
    for (int reg = 0; reg < 16; ++reg) { const int s = sb * 32 + crow(reg, hh); const float w = (s <= t && s < L) ? __expf(sm[s] + bmt) : 0.f; x[reg] *= w; den1 += x[reg]; }
#pragma unroll
    for (int st = 0; st < 2; ++st) { u32x4 p; p.x = pk2(x[8 * st], x[8 * st + 1]); p.y = pk2(x[8 * st + 2], x[8 * st + 3]); p.z = pk2(x[8 * st + 4], x[8 * st + 5]); p.w = pk2(x[8 * st + 6], x[8 * st + 7]);
        const LAS bf16_t* vv = VT + r31 * VT_STRIDE + sb * 32 + 16 * st + 4 * hh; const u32x2 v0 = *(const LAS u32x2*)vv, v1 = *(const LAS u32x2*)(vv + 8);
        const u32x4 vb = (u32x4){v0.x, v0.y, v1.x, v1.y};
        acc1 = MFMA32(__builtin_bit_cast(bf16x8, p), __builtin_bit_cast(bf16x8, vb), acc1); }
}
constexpr int QS_ROW = 136;
DI void mlstm_out(Frame& F, int item) {
    const int hd = item & 3, c = (item >> 2) % NCH, n = (item >> 2) / NCH;
    const int t0 = c == 0 ? 0 : 16 + 64 * (c - 1), L = c == 0 ? 16 : 64, R0 = n * LP + t0, ntb = c == 0 ? 1 : 2;
    LAS bf16_t* Qs = (LAS bf16_t*)F.lds; LAS bf16_t* Ks = Qs + 64 * QS_ROW;
    LAS bf16_t* VT = Ks + 64 * QS_ROW + F.wave * 32 * VT_STRIDE;
    LAS float* sm = (LAS float*)(F.lds + (2 * 64 * QS_ROW + 256 * VT_STRIDE) * 2) + F.wave * 512;
    const bf16_t* QK = (const bf16_t*)(F.ws + WS_QK); const bf16_t* V = (const bf16_t*)(F.ws + WS_HID) + (size_t)MR * 4096;
    const bf16_t* CJ = (const bf16_t*)(F.ws + WS_XA) + (size_t)item * 32768; const float* NJ = (const float*)(F.ws + WS_NJ) + item * 128;
    float* HU = (float*)(F.ws + WS_US5);
    const int lane = F.lane, r31 = lane & 31, hh = lane >> 5, tid = F.tid;
    const bool valid = lane < L;
    const float m0 = ((const float*)(F.ws + WS_ITS))[2 * NITEM + item];
    bf16x8 cf[8];
#pragma unroll
    for (int ks = 0; ks < 8; ++ks) cf[ks] = *(const bf16x8*)(CJ + (F.wave * 32 + r31) * 128 + ks * 16 + 8 * hh);
#pragma unroll
    for (int i = 0; i < 2; ++i) { const int e = tid + i * 512, row = e >> 4, c16 = e & 15; const bf16_t* src = QK + (size_t)(R0 + row) * 1024 + hd * 128 + c16 * 8;
        const u32x4 q = *(const u32x4*)src, k = *(const u32x4*)(src + 512);
        *(LAS u32x4*)(Qs + row * QS_ROW + c16 * 8) = q; *(LAS u32x4*)(Ks + row * QS_ROW + c16 * 8) = k; }
    { const float b = valid ? ((const float*)(F.ws + WS_GB))[(size_t)(R0 + lane) * 4 + hd] : 0.f, ig = valid ? ((const float*)(F.ws + WS_GI))[(size_t)(R0 + lane) * 4 + hd] : 0.f;
      const float cs = valid ? ig - b : -INFINITY; float pm = cs;
      for (int o = 1; o < 64; o <<= 1) { const float t = __shfl_up(pm, o); if (lane >= o) pm = fmaxf(pm, t); }
      const float bm = -fmaxf(m0, pm);
      sm[lane] = cs; sm[64 + lane] = bm; sm[128 + lane] = __expf(m0 + bm); sm[448 + lane] = __expf(bm - b); sm[256 + lane] = NJ[lane]; sm[320 + lane] = NJ[64 + lane]; }
#pragma unroll
    for (int i = 0; i < 4; ++i) { const int s = 16 * i + (lane >> 2), v8 = (lane & 3) * 8; u32x4 w = (u32x4){0u, 0u, 0u, 0u};
        if (s < L) w = *(const u32x4*)(V + (size_t)(R0 + s) * 1024 + hd * 256 + F.wave * 32 + v8);
        const unsigned ww[4] = {w.x, w.y, w.z, w.w};
#pragma unroll
        for (int j = 0; j < 4; ++j) { VT[(v8 + 2 * j) * VT_STRIDE + s] = (bf16_t)(ww[j] & 0xffffu); VT[(v8 + 2 * j + 1) * VT_STRIDE + s] = (bf16_t)(ww[j] >> 16); } }
    __syncthreads();
#pragma unroll
    for (int tb = 0; tb < 2; ++tb) { if (tb < ntb) {
        const int t = tb * 32 + r31; const float bmt = sm[64 + t];
        bf16x8 qf[8];
#pragma unroll
        for (int ks = 0; ks < 8; ++ks) qf[ks] = *(const LAS bf16x8*)(Qs + t * QS_ROW + ks * 16 + 8 * hh);
        float den2 = 0.f;
#pragma unroll
        for (int ks = 0; ks < 8; ++ks) { const u32x4 w = __builtin_bit_cast(u32x4, qf[ks]); const LAS float* nn = sm + 256 + ks * 16 + 8 * hh;
            den2 += bflo(w.x) * nn[0] + bfhi(w.x) * nn[1] + bflo(w.y) * nn[2] + bfhi(w.y) * nn[3] + bflo(w.z) * nn[4] + bfhi(w.z) * nn[5] + bflo(w.w) * nn[6] + bfhi(w.w) * nn[7]; }
        den2 += __shfl_xor(den2, 32);
        f32x16 acc1 = zero16(), acc2 = zero16(); float den1 = 0.f;
#pragma unroll
        for (int sb = 0; sb < 2; ++sb) { if (sb <= tb) {
            bf16x8 kf[8];
#pragma unroll
            for (int ks = 0; ks < 8; ++ks) kf[ks] = *(const LAS bf16x8*)(Ks + (sb * 32 + r31) * QS_ROW + ks * 16 + 8 * hh);
            out_xtile(kf, qf, sb, t, L, bmt, sm, VT, r31, hh, acc1, den1); } }
#pragma unroll
        for (int ks = 0; ks < 8; ++ks) acc2 = MFMA32(qf[ks], cf[ks], acc2);
        den1 += __shfl_xor(den1, 32);
        { const float den = den1 + sm[128 + t] * den2; if (hh == 0) sm[192 + t] = 1.0f / fmaxf(fabsf(den), sm[448 + t]); }
        LDS_WAIT();
#pragma unroll
        for (int reg = 0; reg < 16; ++reg) { const int tt = tb * 32 + crow(reg, hh);
            if (tt < L) HU[(size_t)(R0 + tt) * 1024 + hd * 256 + F.wave * 32 + r31] = (acc1[reg] + sm[128 + tt] * acc2[reg]) * sm[192 + tt]; }
    } }
    __syncthreads();
}
DI void mlstm_sample(Frame& F, int chain) {
    const Params& P = *F.P;
    const int n = chain >> 2, hd = chain & 3, R0 = PROWS + n * 8;
    LAS float* qs = (LAS float*)F.lds;
    LAS float* ks = qs + 1024;
    LAS float* vs = ks + 1024;
    LAS float* ss = vs + 2048;
    LAS float* ga = ss + 64;
    const float* ZIF = (const float*)(F.ws + WS_ZIF); const float* QKPRE = (const float*)(F.ws + WS_QKPRE);
    const bf16_t* V = (const bf16_t*)(F.ws + WS_HID) + (size_t)MR * 4096; float* HU = (float*)(F.ws + WS_US5);
    const int tid = F.tid, lane = F.lane;
    const float m0 = P.in[I_MM][chain];
    if (F.wave == 0) { const bool valid = lane < 8; const int R = R0 + lane;
        const float ig = valid ? ZIF[(size_t)R * 8 + hd] + P.in[I_MBI][hd] : 0.f;
        const float lf = valid ? log_sigmoid(ZIF[(size_t)R * 8 + 4 + hd] + P.in[I_MBF][hd]) : 0.f;
        float b = lf; for (int o = 1; o < 64; o <<= 1) { const float t = __shfl_up(b, o); if (lane >= o) b += t; }
        const float cs = valid ? ig - b : -INFINITY; float pm = cs;
        for (int o = 1; o < 64; o <<= 1) { const float t = __shfl_up(pm, o); if (lane >= o) pm = fmaxf(pm, t); }
        const float bm = -fmaxf(m0, pm), mt = b - bm;
        const float bL = __shfl(b, 7), mnew = __shfl(mt, 7);
        if (valid) { ga[lane] = __expf(bL - b + ig - mnew); ga[8 + lane] = cs; ga[16 + lane] = bm; ga[24 + lane] = __expf(m0 + bm); ga[32 + lane] = __expf(-mt); }
        if (lane == 0) { ga[56] = __expf(bL + m0 - mnew); P.out[O_SM + chain] = mnew; }
    }
    for (int e = tid; e < 2048; e += 512) { const int s = e >> 8, ch = e & 255, col = ch < 128 ? hd * 128 + ch : 512 + hd * 128 + (ch - 128);
        float x[4];
#pragma unroll
        for (int j = 0; j < 4; ++j) { const int t = s - 3 + j; x[j] = t >= 0 ? QKPRE[(size_t)(R0 + t) * 1024 + col] : P.in[I_MCONV][((size_t)n * 3 + (3 + t)) * 1024 + col]; }
        const float v = conv1(P, x[0], x[1], x[2], x[3], col);
        if (ch < 128) qs[s * 128 + ch] = v * 0.08838834764831845f; else ks[s * 128 + ch - 128] = v; }
    for (int e = tid; e < 2048; e += 512) { const int s = e >> 8, v = e & 255; vs[e] = bf1(V[(size_t)(R0 + s) * 1024 + hd * 256 + v]); }
    __syncthreads();
    if (F.wave == 0) { const int t = lane >> 3, s = lane & 7; float d = 0.f;
        if (s <= t) { for (int k = 0; k < 128; ++k) d += qs[t * 128 + k] * ks[s * 128 + k]; d *= __expf(ga[8 + s] + ga[16 + t]); }
        ss[lane] = d; }
    else if (F.wave == 1) { const int t = lane >> 3, part = lane & 7; float d = 0.f;
        for (int k = part * 16; k < part * 16 + 16; ++k) d += P.in[I_MN][chain * 128 + k] * qs[t * 128 + k];
        d += __shfl_xor(d, 1); d += __shfl_xor(d, 2); d += __shfl_xor(d, 4); if (part == 0) ga[40 + t] = d; }
    __syncthreads();
    if (tid < 8) { float den = 0.f; for (int s = 0; s < 8; ++s) den += ss[tid * 8 + s]; den += ga[24 + tid] * ga[40 + tid]; ga[48 + tid] = 1.0f / fmaxf(fabsf(den), ga[32 + tid]); }
    __syncthreads();
    { const float decay = ga[56];
      const float* C0 = P.in[I_MC] + (size_t)chain * 32768; float* Cn = P.out + O_SC + (size_t)chain * 32768;
      { const int r31 = lane & 31, hh = lane >> 5; f32x16 acc = zero16();
        f32x4 ca[8], cb[8];
#pragma unroll
        for (int kq = 0; kq < 8; ++kq) { const float* cp = C0 + (F.wave * 32 + r31) * 128 + kq * 16 + 8 * hh; ca[kq] = *(const f32x4*)cp; cb[kq] = *(const f32x4*)(cp + 4); }
#pragma unroll
        for (int kq = 0; kq < 8; ++kq) { f32x4 qa = (f32x4){0.f, 0.f, 0.f, 0.f}, qb = qa;
            if (r31 < 8) { const LAS float* qp = qs + r31 * 128 + kq * 16 + 8 * hh; qa = *(const LAS f32x4*)qp; qb = *(const LAS f32x4*)(qp + 4); }
            acc = MFMA32(cvt_frag(ca[kq], cb[kq]), cvt_frag(qa, qb), acc); }
        if (r31 < 8) { const int t = r31; const float it = ga[24 + t], iv = ga[48 + t];
#pragma unroll
            for (int reg = 0; reg < 16; ++reg) { const int v = F.wave * 32 + crow(reg, hh); float sv = 0.f;
#pragma unroll
                for (int s = 0; s < 8; ++s) sv += ss[t * 8 + s] * vs[s * 256 + v];
                HU[(size_t)(R0 + t) * 1024 + hd * 256 + v] = (sv + it * acc[reg]) * iv; } } }
      { const int k4 = tid & 31, vr = tid >> 5;
        f32x4 kr[8];
#pragma unroll
        for (int t = 0; t < 8; ++t) kr[t] = *(const LAS f32x4*)(ks + t * 128 + k4 * 4);
#pragma unroll 1
        for (int p0 = 0; p0 < 16; p0 += 4) { f32x4 c0s[4];
#pragma unroll
            for (int q = 0; q < 4; ++q) c0s[q] = __builtin_nontemporal_load((const f32x4*)(C0 + ((p0 + q) * 16 + vr) * 128 + k4 * 4));
#pragma unroll
            for (int q = 0; q < 4; ++q) { const int v = (p0 + q) * 16 + vr; f32x4 cn = c0s[q] * decay;
#pragma unroll
                for (int s = 0; s < 8; ++s) cn += kr[s] * (ga[s] * vs[s * 256 + v]);
                __builtin_nontemporal_store(cn, (f32x4*)(Cn + v * 128 + k4 * 4)); } } }
      if (tid < 128) { float nn = decay * P.in[I_MN][chain * 128 + tid]; for (int s = 0; s < 8; ++s) nn += ga[s] * ks[s * 128 + tid]; P.out[O_SN + chain * 128 + tid] = nn; } }
    __syncthreads();
}
DI void yml_row(Frame& F, int r) {
    const float* HU = (const float*)(F.ws + WS_US5) + (size_t)r * 1024; const bf16_t* SG = (const bf16_t*)(F.ws + WS_SIGO) + (size_t)r * 1024;
    u32x2* o = (u32x2*)((bf16_t*)(F.ws + WS_QKPRE) + (size_t)r * 1024);
    if (r >= NTOK) { for (int j = 0; j < 4; ++j) o[64 * j + F.lane] = (u32x2){0u, 0u}; return; }
#pragma unroll
    for (int j = 0; j < 4; ++j) { const f32x4 v = ((const f32x4*)HU)[64 * j + F.lane]; const float s = wave_sum((v.x * v.x + v.y * v.y) + (v.z * v.z + v.w * v.w));
        const float rn = rsqrtf(s * (1.0f / 256.0f) + EPS); const f32x4 g = ((const f32x4*)F.P->in[I_MNORM])[64 * j + F.lane]; const u32x2 sg = ((const u32x2*)SG)[64 * j + F.lane];
        o[64 * j + F.lane] = (u32x2){pk2(v.x * rn * g.x * bflo(sg.x), v.y * rn * g.y * bfhi(sg.x)), pk2(v.z * rn * g.z * bflo(sg.y), v.w * rn * g.w * bfhi(sg.y))}; }
}


DI int grab_item(Frame& F, unsigned* cnt) {
    volatile LAS int* slot = (volatile LAS int*)(F.lds + 288 * 512 + 768);
    if (F.tid == 0) *slot = (int)__hip_atomic_fetch_add(cnt, 1u, __ATOMIC_RELAXED, __HIP_MEMORY_SCOPE_AGENT);
    __syncthreads();
    const int v = *slot;
    __syncthreads();
    return v;
}

#define XB_TMO      128
#define XB_XCNT(j)  (256  + 64 * (j))
#define XB_XSUB(j)  (1280 + 64 * (j))
#define XB_XGEN(j)  (2304 + 64 * (j))
#define XB_TOP      3328
#define XB_TOPGEN   3392
#define XCD_BAR_WORDS 3456
#define XB_SPIN_CAP (1u << 22)
DI unsigned xb_ld(unsigned* p)              { return __hip_atomic_load(p, __ATOMIC_RELAXED, __HIP_MEMORY_SCOPE_AGENT); }
DI unsigned xb_add(unsigned* p, unsigned v) { return __hip_atomic_fetch_add(p, v, __ATOMIC_RELAXED, __HIP_MEMORY_SCOPE_AGENT); }
DI unsigned xb_xcc_id() { return (unsigned)__builtin_amdgcn_s_getreg((3 << 11) | 20) & 0xFu; }
#define XB_SPIN(cond, bar) do { unsigned _sp = 0; while (cond) { __builtin_amdgcn_s_sleep(1); \
    if ((++_sp & 255u) == 0u) { if (xb_ld(&(bar)[XB_TMO])) break; if (_sp > XB_SPIN_CAP) { atomicAdd(&(bar)[XB_TMO], 1u); break; } } } } while (0)
struct XcdBarrier { unsigned* bar; unsigned x; volatile LAS unsigned* st; };
DI XcdBarrier xcd_barrier_post(unsigned* bar, volatile LAS unsigned* st) {
    XcdBarrier b; b.bar = bar; b.x = xb_xcc_id(); b.st = st;
    if (threadIdx.x == 0) (void)xb_add(&bar[XB_XCNT(b.x)], 1u);
    return b;
}
DI void xcd_barrier_complete(unsigned* bar, unsigned x, unsigned& nloc, unsigned& nx) {
    const unsigned G = gridDim.x * gridDim.y * gridDim.z;
    unsigned sum, cnt, mine, sp = 0u;
    for (;;) {
        sum = 0u; cnt = 0u; mine = 0u;
#pragma unroll
        for (unsigned j = 0; j < 16; ++j) { const unsigned c = xb_ld(&bar[XB_XCNT(j)]); sum += c; cnt += (c > 0u) ? 1u : 0u; mine = (j == x) ? c : mine; }
        if (sum == G) break;
        __builtin_amdgcn_s_sleep(1);
        if ((++sp & 255u) == 0u) { if (xb_ld(&bar[XB_TMO])) break; if (sp > XB_SPIN_CAP) { atomicAdd(&bar[XB_TMO], 1u); break; } }
    }
    nloc = mine > 0u ? mine : 1u; nx = cnt > 0u ? cnt : 1u;
}
DI void xcd_barrier(const XcdBarrier& b) {
    asm volatile("s_waitcnt vmcnt(0)" ::: "memory");
    __syncthreads();
    if (threadIdx.x == 0) {
        unsigned* bar = b.bar;
        __builtin_amdgcn_s_waitcnt(0);
        unsigned nloc = b.st[0], nx = b.st[1];
        if (nloc == 0u) { xcd_barrier_complete(bar, b.x, nloc, nx); b.st[0] = nloc; b.st[1] = nx; }
        const unsigned old = xb_add(&bar[XB_XSUB(b.x)], 1u);
        const unsigned gen = old / nloc;
        if (old + 1u == (gen + 1u) * nloc) {
            __builtin_amdgcn_fence(__ATOMIC_RELEASE, "agent");
            asm volatile("s_waitcnt vmcnt(0)" ::: "memory");
            const unsigned og = xb_add(&bar[XB_TOP], 1u);
            const unsigned tg = og / nx;
            if (og + 1u == (tg + 1u) * nx) xb_add(&bar[XB_TOPGEN], 1u);
            else XB_SPIN(xb_ld(&bar[XB_TOPGEN]) == tg, bar);
            __builtin_amdgcn_fence(__ATOMIC_ACQUIRE, "agent");
            xb_add(&bar[XB_XGEN(b.x)], 1u);
            asm volatile("s_waitcnt vmcnt(0)" ::: "memory");
        } else {
            XB_SPIN(xb_ld(&bar[XB_XGEN(b.x)]) == gen, bar);
            __builtin_amdgcn_fence(__ATOMIC_ACQUIRE, "agent");
            asm volatile("s_waitcnt vmcnt(0)" ::: "memory");
        }
    }
    __syncthreads();
}

__global__ void __launch_bounds__(512, 2) fwd_kernel(Params prm) {
    extern __shared__ __attribute__((aligned(16))) unsigned char lds_raw[];
    cg::grid_group grid = cg::this_grid();
    Frame F; F.lds = (LAS unsigned char*)lds_raw; F.P = &prm; F.ws = prm.ws; F.tid = threadIdx.x; F.lane = F.tid & 63; F.wave = __builtin_amdgcn_readfirstlane(F.tid >> 6); F.G = gridDim.x; F.bid = blockIdx.x;
    const Params& P = prm;
    unsigned char* ws = prm.ws;
    const int gw = F.bid * 8 + F.wave, NGW = F.G * 8;
    const int lo = prm.ph_lo, hi = prm.ph_hi;
#define IN(k) (lo <= (k) && (k) < hi)
#define SEAM(k) do { if (IN(k) && IN((k) + 1)) { xcd_barrier(xbar); } } while (0)
    volatile LAS unsigned* xst = (volatile LAS unsigned*)(F.lds + 288 * 512 + 512);
    if (F.tid < 2) xst[F.tid] = 0u;
    __syncthreads();
    XcdBarrier xbar; xbar.bar = (unsigned*)(ws + WS_BAR); xbar.x = 0; xbar.st = xst;
    if (hi - lo > 1) xbar = xcd_barrier_post((unsigned*)(ws + WS_BAR), xst);
    if (lo > 4096) grid.sync();
#ifndef DUP_MASK
#define DUP_MASK 0
#endif
#define PH(k) for (int rep_ = 0; rep_ < (IN(k) ? 1 + ((DUP_MASK >> (k)) & 1) : 0); ++rep_)
    bf16_t* W1 = (bf16_t*)(ws + WS_WFF); bf16_t* XA = (bf16_t*)(ws + WS_XA); bf16_t* HID = (bf16_t*)(ws + WS_HID); float* H = (float*)(ws + WS_H);
    float* SSQ = (float*)(ws + WS_SSQ);

    PH(0) {
        LAS float* scr = (LAS float*)(F.lds + F.wave * 8704);
        for (int i = F.bid * 512 + F.tid; i < 3 * MR; i += F.G * 512) SSQ[i] = 0.f;
        if (F.bid == 0 && F.tid < 4) ((unsigned*)(ws + WS_CNT))[F.tid * 64] = 0u;
        for (int i = F.bid * 512 + F.tid; i < (MR - NTOK) * 1024 / 2; i += F.G * 512) ((unsigned*)((bf16_t*)(ws + WS_YS5P) + (size_t)NTOK * 1024))[i] = 0u;
        for (int it = gw; it < 32 * 264; it += NGW) { const int kb = it / 264, nb = it - kb * 264, d0 = nb * 32;
            int src = d0, nv = 32; if (d0 >= 8192) { src = 4096; nv = d0 == 8192 ? 8 : 0; } else if (d0 >= 4096) src = d0 + 8;
            tr_item(P.in[I_WIN], 8200, src, nv, (bf16_t*)(ws + WS_WIN), D, d0, kb * 64, scr, F.lane); }
        for (int it = gw; it < 16 * 32; it += NGW) { const int kb = it / 32, nb = it - kb * 32; tr_item(P.in[I_WGLU], 1024, nb * 32, 32, (bf16_t*)(ws + WS_WGLU), 1024, nb * 32, kb * 64, scr, F.lane); }
        for (int it = gw; it < 16 * 64; it += NGW) { const int kb = it / 64, nb = it - kb * 64; tr_item(P.in[I_WBS], 2048, nb * 32, 32, (bf16_t*)(ws + WS_WBS), 1024, nb * 32, kb * 64, scr, F.lane);
            tr_item(P.in[I_WBM], 2048, nb * 32, 32, (bf16_t*)(ws + WS_WBM), 1024, nb * 32, kb * 64, scr, F.lane); }
        for (int it = gw; it < 32 * 64; it += NGW) { const int kb = it / 64, nb = it - kb * 64; tr_item(P.in[I_WOUT], 2048, nb * 32, 32, (bf16_t*)(ws + WS_WOUT), 2048, nb * 32, kb * 64, scr, F.lane); }
        for (int it = gw; it < FFN_ITEMS; it += NGW) ffn_conv_item(P.in[I_F1G], P.in[I_F1U], P.in[I_F1D], W1, FFN_ITEMS - 1 - it, scr, F.lane);
        for (int r = gw; r < MR; r += NGW) rms_row(F, r, P.in[I_F1N], XA);
        __syncthreads();
        if (F.bid >= 192) s5_precompute(F, F.bid - 192);
    }
    SEAM(0);
    PH(1) { pg8::Gemm g{XA, XA, W1, W1, D}; pg8::Order S; S.init(MR, 2 * DFF, F.G, F.bid, 1, 2); EpiSwiglu E{HID, nullptr}; pg8::gemm_phase(F.lds, g, S, E); }
    SEAM(1);
    PH(2) { pg8::Gemm g{HID, HID, W1 + (size_t)2 * DFF * D, W1 + (size_t)2 * DFF * D, DFF}; pg8::Order S; S.init(MR, D, F.G, F.bid, 1, 4, 1);
        EpiResid<0> E{&prm}; pg8::gemm_phase(F.lds, g, S, E); }
    SEAM(2);
    PH(3) { const bf16_t* W = (const bf16_t*)(ws + WS_WIN); pg8::Gemm g{XA, XA, W, W, D}; pg8::Order S; S.init(MR, NIN, F.G, F.bid, 1, 1);
        EpiWin E{(float*)(ws + WS_US5), (float*)(ws + WS_QKPRE), HID + (size_t)MR * 4096, (bf16_t*)(ws + WS_SIGO), HID, (float*)(ws + WS_ZIF), SSQ}; pg8::gemm_phase(F.lds, g, S, E); }
    SEAM(3);
    PH(4) {
        for (;;) { const int it = grab_item(F, (unsigned*)(ws + WS_CNT)); if (it >= NITEM + 320) break; if (it < 320) s5_item(F, it); else mlstm_prep(F, it - 320); }
        const float* QKPRE = (const float*)(ws + WS_QKPRE);
        for (int i = F.bid * 512 + F.tid; i < (NB + NS) * 3 * 1024; i += F.G * 512) { const int col = i & 1023, rr = i >> 10, j = rr % 3, b = rr / 3;
            if (b < NB) P.out[O_PCONV + ((size_t)b * 3 + j) * 1024 + col] = QKPRE[(size_t)(b * LP + LP - 3 + j) * 1024 + col];
            else P.out[O_SCONV + ((size_t)(b - NB) * 3 + j) * 1024 + col] = QKPRE[(size_t)(PROWS + (b - NB) * 8 + 5 + j) * 1024 + col]; }
    }
    SEAM(4);
    PH(5) mlstm_scan(F);
    SEAM(5);
    PH(6) {
        for (;;) { const int it = grab_item(F, (unsigned*)(ws + WS_CNT) + 64); if (it >= NITEM + NS * 4) break;
            if (it < NITEM) mlstm_out(F, it); else mlstm_sample(F, it - NITEM); }
        { LAS float* scr = (LAS float*)(F.lds + F.wave * 8704);
          for (;;) { const int it = grab_item(F, (unsigned*)(ws + WS_CNT) + 128); if (it >= FFN_ITEMS / 8) break;
              ffn_conv_item(P.in[I_F2G], P.in[I_F2U], P.in[I_F2D], W1, FFN_ITEMS - 1 - (it * 8 + F.wave), scr, F.lane); } }
    }
    SEAM(6);
    PH(7) {
        bf16_t* YML = (bf16_t*)(ws + WS_QKPRE); bf16_t* YS5 = YML + (size_t)MR * 1024;
        const bf16_t* W = (const bf16_t*)(ws + WS_WGLU); const bf16_t* YP = (const bf16_t*)(ws + WS_YS5P);
        pg8::Gemm g{YP, YP, W, W, 1024}; pg8::Order S; S.init(MR, 1024, F.G, F.bid, 1, 1); EpiGlu E{YP, YS5}; pg8::gemm_phase(F.lds, g, S, E);
        const int nidle = F.G - 148;
        if (F.bid >= 148) for (int r = (F.bid - 148) * 8 + F.wave; r < MR; r += nidle * 8) yml_row(F, r);
    }
    SEAM(7);
    PH(8) { const bf16_t* YML = (const bf16_t*)(ws + WS_QKPRE); const bf16_t* YS5 = YML + (size_t)MR * 1024;
        pg8::Gemm g{YS5, YML, (const bf16_t*)(ws + WS_WBS), (const bf16_t*)(ws + WS_WBM), 1024}; pg8::Order S; S.init(MR, D, F.G, F.bid, 2, 4, 1);
        EpiBranch E{HID, (bf16_t*)(ws + WS_US5)}; pg8::gemm_phase(F.lds, g, S, E); }
    SEAM(8);
    PH(9) { const bf16_t* MG = (const bf16_t*)(ws + WS_US5); const bf16_t* W = (const bf16_t*)(ws + WS_WOUT); pg8::Gemm g{MG, MG, W, W, D}; pg8::Order S; S.init(MR, D, F.G, F.bid, 1, 4);
        EpiResid<1> E{&prm}; pg8::gemm_phase(F.lds, g, S, E); }
    SEAM(9);
    PH(10) { pg8::Gemm g{XA, XA, W1, W1, D}; pg8::Order S; S.init(MR, 2 * DFF, F.G, F.bid, 1, 2, 1); EpiSwiglu E{HID, SSQ + MR}; pg8::gemm_phase(F.lds, g, S, E); }
    SEAM(10);
    PH(11) { pg8::Gemm g{HID, HID, W1 + (size_t)2 * DFF * D, W1 + (size_t)2 * DFF * D, DFF}; pg8::Order S; S.init(MR, D, F.G, F.bid, 1, 4);
        EpiResid<2> E{&prm}; pg8::gemm_phase(F.lds, g, S, E); }
    SEAM(11);
    PH(12) {
        for (int r = gw; r < NTOK; r += NGW) { float* o;
            if (r < PROWS) { const int b = r / LP, t = r - b * LP; if (t < 16) continue; o = P.out + O_YP + ((size_t)b * 2048 + (t - 16)) * D; } else o = P.out + O_YS + (size_t)(r - PROWS) * D;
            const float rs = rsqrtf(SSQ[2 * MR + r] * (1.0f / D) + EPS); const f32x4* h = (const f32x4*)(H + (size_t)r * D); const f32x4* gn = (const f32x4*)P.in[I_FINN];
#pragma unroll
            for (int j = 0; j < 8; ++j) __builtin_nontemporal_store(__builtin_nontemporal_load(h + 64 * j + F.lane) * rs * gn[64 * j + F.lane], (f32x4*)o + 64 * j + F.lane); }
    }
#undef IN
#undef SEAM
}

#ifndef N_LAUNCH_SPLIT
#define N_LAUNCH_SPLIT 0
#endif
#ifndef LAUNCH_LIST
#define LAUNCH_LIST {0, 1, 2, 3, 4, 5, 6, 7, 8, 9, 10, 11, 12}
#endif
extern "C" void kernel_launch(void* const* d_in, const int* in_sizes, int n_in, void* d_out, int out_size, void* d_ws, size_t ws_size, hipStream_t stream) {
    static int grid = 0;
    if (grid == 0) {
        if (n_in != 37 || (size_t)out_size != O_END || ws_size < WS_END) { fprintf(stderr, "kernel_launch: unexpected shapes (n_in %d, out %d, ws %zu, need %zu)\n", n_in, out_size, ws_size, (size_t)WS_END); grid = -1; return; }
        int dev = 0, cus = 0, per_cu = 0;
        hipGetDevice(&dev); hipDeviceGetAttribute(&cus, hipDeviceAttributeMultiprocessorCount, dev);
        if (hipFuncSetAttribute((const void*)fwd_kernel, hipFuncAttributeMaxDynamicSharedMemorySize, LDS_BYTES) != hipSuccess) { fprintf(stderr, "kernel_launch: hipFuncSetAttribute failed\n"); grid = -1; return; }
        if (hipOccupancyMaxActiveBlocksPerMultiprocessor(&per_cu, (const void*)fwd_kernel, 512, LDS_BYTES) != hipSuccess || per_cu < 1) per_cu = 1;
        (void)hipGetLastError();
        grid = cus;
    }
    if (grid < 0) return;
    Params p{};
    for (int i = 0; i < 37; ++i) p.in[i] = (const float*)d_in[i];
    p.out = (float*)d_out; p.ws = (unsigned char*)d_ws;
#if N_LAUNCH_SPLIT
    { const int plist[] = LAUNCH_LIST; for (int k : plist) { p.ph_lo = k; p.ph_hi = k + 1; hipLaunchKernelGGL(fwd_kernel, dim3(grid), dim3(512), LDS_BYTES, stream, p); } }
#else
    p.ph_lo = 0; p.ph_hi = 13;
    (void)hipMemsetAsync((char*)d_ws + WS_BAR, 0, 16384, stream);
    void* args[] = {&p};
    hipError_t e = hipLaunchCooperativeKernel((const void*)fwd_kernel, dim3(grid), dim3(512), args, LDS_BYTES, stream);
    if (e != hipSuccess) fprintf(stderr, "cooperative launch failed: %s (grid %d)\n", hipGetErrorString(e), grid);
#endif
}
```

```cpp
#include <hip/hip_runtime.h>
#include <hip/hip_cooperative_groups.h>
#include <cstdio>
#include <cstdint>
namespace cg = cooperative_groups;

#define LAS __attribute__((address_space(3)))
typedef unsigned short bf16_t;
typedef short bf16x8 __attribute__((ext_vector_type(8)));
typedef float f32x2 __attribute__((ext_vector_type(2)));
typedef float f32x4 __attribute__((ext_vector_type(4)));
typedef float f32x16 __attribute__((ext_vector_type(16)));
typedef unsigned u32x4 __attribute__((ext_vector_type(4)));
typedef unsigned u32x2 __attribute__((ext_vector_type(2)));
#define DI __device__ __forceinline__
#define LDS_WAIT() asm volatile("s_waitcnt lgkmcnt(0)" ::: "memory")

constexpr int D = 2048, DFF = 5632, NB = 4, LP = 2064, NS = 128, LS = 8;
constexpr int PROWS = NB * LP;
constexpr int NTOK = PROWS + NS * LS;
constexpr int MR = 9472;
constexpr int NIN = 8448;
constexpr int NCH = 33;
constexpr int NITEM = NB * NCH * 4;
constexpr float EPS = 1e-6f;

constexpr size_t AL(size_t x) { return (x + 255) & ~(size_t)255; }
constexpr size_t WS_SSQ = 0;
constexpr size_t WS_BAR = AL(WS_SSQ + 3 * MR * 4);
constexpr size_t WS_CNT = AL(WS_BAR + 16384);
constexpr size_t WS_ZIF = AL(WS_CNT + 4 * 256);
constexpr size_t WS_GB = AL(WS_ZIF + MR * 8 * 4);
constexpr size_t WS_GI = AL(WS_GB + MR * 4 * 4);
constexpr size_t WS_ITS = AL(WS_GI + MR * 4 * 4);
constexpr size_t WS_DN = AL(WS_ITS + 3 * NITEM * 4);
constexpr size_t WS_NJ = AL(WS_DN + NITEM * 128 * 4);
constexpr size_t WS_A8 = AL(WS_NJ + NITEM * 128 * 4);
constexpr size_t WS_S5M = AL(WS_A8 + 64 * 64 * 2 * 4);
constexpr size_t WFF_BYTES = (size_t)2 * DFF * D * 2 + (size_t)D * DFF * 2;
constexpr size_t WS_WFF = AL(WS_S5M + (size_t)64 * 3 * 16384 * 2);
constexpr size_t WS_WIN = AL(WS_WFF + WFF_BYTES);
constexpr size_t WS_WGLU = AL(WS_WIN + (size_t)NIN * D * 2);
constexpr size_t WS_WBS = AL(WS_WGLU + (size_t)1024 * 1024 * 2);
constexpr size_t WS_WBM = AL(WS_WBS + (size_t)2048 * 1024 * 2);
constexpr size_t WS_WOUT = AL(WS_WBM + (size_t)2048 * 1024 * 2);
constexpr size_t WS_XA = AL(WS_WOUT + (size_t)2048 * 2048 * 2);
constexpr size_t WS_HID = AL(WS_XA + (size_t)MR * D * 2);
constexpr size_t WS_H = AL(WS_HID + (size_t)MR * DFF * 2);
constexpr size_t WS_US5 = AL(WS_H + (size_t)MR * D * 4);
constexpr size_t WS_QKPRE = AL(WS_US5 + (size_t)MR * 1024 * 4);
constexpr size_t WS_SIGO = AL(WS_QKPRE + (size_t)MR * 1024 * 4);
constexpr size_t WS_QK = AL(WS_SIGO + (size_t)MR * 1024 * 2);
constexpr size_t WS_YS5P = AL(WS_QK + (size_t)MR * 1024 * 2);
constexpr size_t WS_END = AL(WS_YS5P + (size_t)MR * 1024 * 2);
static_assert((size_t)NITEM * 32768 * 4 <= WFF_BYTES, "DC overlay");
static_assert((size_t)NITEM * 32768 * 2 <= (size_t)MR * D * 2, "CJ overlay");

constexpr size_t O_YP = 0, O_YS = O_YP + (size_t)NB * 2048 * 2048, O_PS5R = O_YS + (size_t)NS * LS * 2048, O_PS5I = O_PS5R + NB * 4096,
                 O_PC = O_PS5I + NB * 4096, O_PN = O_PC + (size_t)NB * 4 * 32768, O_PM = O_PN + NB * 4 * 128, O_PCONV = O_PM + NB * 4,
                 O_SS5R = O_PCONV + NB * 3 * 1024, O_SS5I = O_SS5R + (size_t)NS * 4096, O_SC = O_SS5I + (size_t)NS * 4096,
                 O_SN = O_SC + (size_t)NS * 4 * 32768, O_SM = O_SN + NS * 4 * 128, O_SCONV = O_SM + NS * 4, O_END = O_SCONV + NS * 3 * 1024;

constexpr int LDS_BYTES = 288 * 512 + 1024;

DI unsigned pk2(float lo, float hi) {
    typedef __bf16 bf2 __attribute__((ext_vector_type(2)));
    f32x2 v = {lo, hi}; bf2 b = __builtin_convertvector(v, bf2); return __builtin_bit_cast(unsigned, b);
}
DI bf16x8 cvt_frag(f32x4 a, f32x4 b) { u32x4 w; w.x = pk2(a.x, a.y); w.y = pk2(a.z, a.w); w.z = pk2(b.x, b.y); w.w = pk2(b.z, b.w); return __builtin_bit_cast(bf16x8, w); }
DI float bflo(unsigned w) { return __uint_as_float(w << 16); }
DI float bfhi(unsigned w) { return __uint_as_float(w & 0xffff0000u); }
DI float bf1(bf16_t v) { return __uint_as_float(((unsigned)v) << 16); }
DI bf16_t f2bf(float f) { return (bf16_t)(pk2(f, 0.f) & 0xffffu); }
DI float sigmoidf_(float x) { return __builtin_amdgcn_rcpf(1.0f + __expf(-x)); }
DI float siluf_(float x) { return x * sigmoidf_(x); }
DI float gelu_tanh(float x) { const float u = 0.7978845608028654f * (x + 0.044715f * x * x * x); return x * sigmoidf_(2.0f * u); }
DI int crow(int reg, int h) { return (reg & 3) + 8 * (reg >> 2) + 4 * h; }
#define MFMA32(a, b, c) __builtin_amdgcn_mfma_f32_32x32x16_bf16((a), (b), (c), 0, 0, 0)
DI f32x16 zero16() { f32x16 z; for (int i = 0; i < 16; ++i) z[i] = 0.f; return z; }
DI float wave_max(float v) { for (int o = 1; o < 64; o <<= 1) v = fmaxf(v, __shfl_xor(v, o)); return v; }
DI float wave_sum(float v) { for (int o = 1; o < 64; o <<= 1) v += __shfl_xor(v, o); return v; }

namespace pg8 {
constexpr int BM = 256, BK = 64, HALF = 128, HTB = HALF * BK * 2, STAGE_BYTES = 8 * HTB, NXCD = 8, WGM = 8;
DI int lds_byte(int r, int c) { const int st = (r >> 4) * 2 + (c >> 5), rr = r & 15, cc = c & 31, ob = rr * 64 + cc * 2; return st * 1024 + (ob ^ (((ob >> 9) & 1) << 5)); }
DI void stage_rc(int b, int& R, int& C) { const int st = b / 1024, sb = b % 1024, swz = sb ^ (((sb >> 9) & 1) << 5); R = (st >> 1) * 16 + swz / 64; C = (st & 1) * 32 + (swz % 64) / 2; }
DI int perm32(int rho) { const int n = rho >> 4, i = rho & 15; return 8 * (i >> 2) + 4 * n + (i & 3); }
struct Unit { int pm, pn, sub, mask; };
struct Gemm { const bf16_t* A0; const bf16_t* A1; const bf16_t* B0; const bf16_t* B1; int K; };
struct Order {
    int nM, nN, nwg, G, c, nsub, full, R, parts;
    DI void init(int M, int N, int G_, int c_, int nsub_, int maxparts) { nM = M / BM; nN = N / BM; nwg = nM * nN; G = G_; c = c_; nsub = nsub_;
        full = nwg / G; R = nwg - full * G; parts = (R > 0 && 4 * R <= G && maxparts >= 4) ? 4 : ((R > 0 && 2 * R <= G && maxparts >= 2) ? 2 : 1); }
    DI void tile(int wgid, Unit& u) const {
        { const int q = nwg / NXCD, r = nwg % NXCD, xcd = wgid % NXCD, off = wgid / NXCD; wgid = (xcd < r ? xcd * (q + 1) : r * (q + 1) + (xcd - r) * q) + off; }
        const int nig = WGM * nN, gid = wgid / nig, fm = gid * WGM, gsz = (nM - fm) < WGM ? (nM - fm) : WGM;
        u.pm = fm + ((wgid % nig) % gsz); u.pn = (wgid % nig) / gsz; }
    DI bool next(int i, Unit& u) const {
        const int ti = i / nsub; u.sub = i - ti * nsub; u.mask = 15;
        if (ti < full || parts < 2) { const long L = (long)ti * G + c; if (L >= nwg) return false; tile((int)L, u); return true; }
        if (ti > full || c >= R * parts) return false;
        const int j = c / parts, part = c - j * parts; tile(full * G + j, u);
        u.mask = parts == 4 ? (1 << part) : (part ? 12 : 3); return true;
    }
};
template <class Epi>
DI void gemm_phase(LAS unsigned char* lds, const Gemm g, const Order S, const Epi E) {
    const int tid = threadIdx.x, wid = __builtin_amdgcn_readfirstlane(tid >> 6), lane = tid & 63, wr = wid >> 2, wc = wid & 3, fr = lane & 15, fq = lane >> 4;
    const int K = g.K, nt = K / BK;
    unsigned voffA[2], voffB[2];
#pragma unroll
    for (int i = 0; i < 2; ++i) { int R, C; stage_rc(tid * 16 + i * 8192, R, C); const int Rb = (R & ~31) + perm32(R & 31);
        voffA[i] = (unsigned)(R * K + C) * 2u; voffB[i] = (unsigned)(Rb * K + C) * 2u; }
    const size_t kstep = (size_t)(BK * 2);
    const size_t hstep = (size_t)HALF * K * 2;
    const size_t tstep = 2 * hstep;
    const unsigned ldsw = (unsigned)wid * 1024u;
    const int aoff = lds_byte(wr * 64 + fr, fq * 8), boff = lds_byte(wc * 32 + fr, fq * 8);
#define PG8_SA(b, h) (((b) * 2 + (h)) * HTB)
#define PG8_SB(b, h) ((4 + (b) * 2 + (h)) * HTB)
#define PG8_STAGE(bufoff, gbase, voff) do { _Pragma("unroll") for (int _i = 0; _i < 2; ++_i) \
        __builtin_amdgcn_global_load_lds((const unsigned*)((const char*)(gbase) + (voff)[_i]), (LAS unsigned*)(lds + (bufoff) + ldsw + _i * 8192), 16, 0, 0); } while (0)
#define PG8_STAGEM(need, bufoff, gbase, voff) do { const bool _n = (need); const char* _b = _n ? (const char*)(gbase) : (const char*)g.A0; _Pragma("unroll") for (int _i = 0; _i < 2; ++_i) \
        __builtin_amdgcn_global_load_lds((const unsigned*)(_b + (_n ? (voff)[_i] : 0u)), (LAS unsigned*)(lds + (bufoff) + ldsw + _i * 8192), 16, 0, 0); } while (0)
#define PG8_LDA(dst, b, h) do { _Pragma("unroll") for (int m = 0; m < 4; ++m) _Pragma("unroll") for (int k = 0; k < 2; ++k) dst[m][k] = *(const LAS bf16x8*)(lds + PG8_SA(b, h) + aoff + m * 2048 + k * 1024); } while (0)
#define PG8_LDB(dst, b, h) do { _Pragma("unroll") for (int n = 0; n < 2; ++n) _Pragma("unroll") for (int k = 0; k < 2; ++k) dst[n][k] = *(const LAS bf16x8*)(lds + PG8_SB(b, h) + boff + n * 2048 + k * 1024); } while (0)
#define PG8_MMA(ai, bj, At, Bt) do { __builtin_amdgcn_s_setprio(1); _Pragma("unroll") for (int m = 0; m < 4; ++m) _Pragma("unroll") for (int n = 0; n < 2; ++n) _Pragma("unroll") for (int k = 0; k < 2; ++k) \
        acc[ai][bj][m][n] = __builtin_amdgcn_mfma_f32_16x16x32_bf16(Bt[n][k], At[m][k], acc[ai][bj][m][n], 0, 0, 0); __builtin_amdgcn_s_setprio(0); } while (0)
#define PG8_WAIT_V(n) asm volatile("s_waitcnt vmcnt(" #n ")" ::: "memory")
#define PG8_WAIT_L(n) asm volatile("s_waitcnt lgkmcnt(" #n ")" ::: "memory")
#define PG8_BAR __builtin_amdgcn_s_barrier()
#define PG8_SCHED __builtin_amdgcn_sched_barrier(0)
    Unit cur, nxt; int ui = 0;
    if (!S.next(0, cur)) return;
    f32x4 acc[2][2][4][2];
#pragma unroll
    for (int a = 0; a < 2; ++a)
#pragma unroll
        for (int b = 0; b < 2; ++b)
#pragma unroll
            for (int m = 0; m < 4; ++m)
#pragma unroll
                for (int n = 0; n < 2; ++n) acc[a][b][m][n] = (f32x4){0.f, 0.f, 0.f, 0.f};
    bf16x8 At[4][2], B0[2][2], B1[2][2];
    const char* cA = (const char*)(cur.sub ? g.A1 : g.A0) + (size_t)cur.pm * tstep; const char* cB = (const char*)(cur.sub ? g.B1 : g.B0) + (size_t)cur.pn * tstep;
    PG8_STAGE(PG8_SB(0, 0), cB, voffB); PG8_STAGE(PG8_SB(0, 1), cB + hstep, voffB); PG8_STAGE(PG8_SA(0, 0), cA, voffA); PG8_STAGE(PG8_SA(0, 1), cA + hstep, voffA);
    if (wr == 1) PG8_BAR;
    PG8_WAIT_V(2); PG8_BAR;
    PG8_STAGE(PG8_SB(1, 0), cB + kstep, voffB); PG8_STAGE(PG8_SA(1, 0), cA + kstep, voffA); PG8_STAGE(PG8_SB(1, 1), cB + hstep + kstep, voffB);
    PG8_WAIT_V(6); PG8_BAR;
    for (;;) {
        const bool has_next = S.next(ui + 1, nxt);
        const char* nA = has_next ? (const char*)(nxt.sub ? g.A1 : g.A0) + (size_t)nxt.pm * tstep : cA; const char* nB = has_next ? (const char*)(nxt.sub ? g.B1 : g.B0) + (size_t)nxt.pn * tstep : cB;
        const int mk = cur.mask;
        for (int t = 0; t < nt; t += 2) {
            const bool last = (t == nt - 2);
            const char* a1 = cA + (size_t)(t + 1) * kstep;
            const char* a2 = last ? nA : cA + (size_t)(t + 2) * kstep; const char* b2 = last ? nB : cB + (size_t)(t + 2) * kstep;
            const char* a3 = a2 + kstep; const char* b3 = b2 + kstep;
            const int mn = (last && has_next) ? nxt.mask : mk;
            PG8_LDB(B0, 0, 0); PG8_LDB(B1, 0, 1); PG8_SCHED; PG8_LDA(At, 0, 0); PG8_STAGEM(mk & 12, PG8_SA(1, 1), a1 + hstep, voffA);
            PG8_WAIT_V(8); PG8_WAIT_L(0); PG8_BAR; if (mk & 1) PG8_MMA(0, 0, At, B0); if (mk & 2) PG8_MMA(0, 1, At, B1); PG8_BAR; PG8_SCHED;
            PG8_LDA(At, 0, 1); PG8_STAGEM(mn & 5, PG8_SB(0, 0), b2, voffB); PG8_STAGEM(mn & 10, PG8_SB(0, 1), b2 + hstep, voffB); PG8_STAGEM(mn & 3, PG8_SA(0, 0), a2, voffA);
            PG8_WAIT_V(8); PG8_WAIT_L(0); PG8_BAR; if (mk & 4) PG8_MMA(1, 0, At, B0); if (mk & 8) PG8_MMA(1, 1, At, B1); PG8_BAR; PG8_SCHED;
            PG8_LDB(B0, 1, 0); PG8_LDB(B1, 1, 1); PG8_SCHED; PG8_LDA(At, 1, 0); PG8_STAGEM(mn & 12, PG8_SA(0, 1), a2 + hstep, voffA);
            PG8_WAIT_V(8); PG8_WAIT_L(0); PG8_BAR; if (mk & 1) PG8_MMA(0, 0, At, B0); if (mk & 2) PG8_MMA(0, 1, At, B1); PG8_BAR; PG8_SCHED;
            PG8_LDA(At, 1, 1); PG8_STAGEM(mn & 5, PG8_SB(1, 0), b3, voffB); PG8_STAGEM(mn & 10, PG8_SB(1, 1), b3 + hstep, voffB); PG8_STAGEM(mn & 3, PG8_SA(1, 0), a3, voffA);
            PG8_WAIT_V(8); PG8_WAIT_L(0); PG8_BAR; if (mk & 4) PG8_MMA(1, 0, At, B0); if (mk & 8) PG8_MMA(1, 1, At, B1); PG8_BAR; PG8_SCHED;
        }
        if (wr == 0) PG8_BAR;
        E(acc, cur, wr, wc, fr, fq);
        if (!has_next) break;
#pragma unroll
        for (int a = 0; a < 2; ++a)
#pragma unroll
            for (int b = 0; b < 2; ++b)
#pragma unroll
                for (int m = 0; m < 4; ++m)
#pragma unroll
                    for (int n = 0; n < 2; ++n) acc[a][b][m][n] = (f32x4){0.f, 0.f, 0.f, 0.f};
        cur = nxt; cA = nA; cB = nB; ++ui;
        if (wr == 1) PG8_BAR;
    }
    PG8_WAIT_V(0);
    PG8_BAR;
#undef PG8_SA
#undef PG8_SB
#undef PG8_STAGE
#undef PG8_STAGEM
#undef PG8_LDA
#undef PG8_LDB
#undef PG8_MMA
#undef PG8_WAIT_V
#undef PG8_WAIT_L
#undef PG8_BAR
#undef PG8_SCHED
}
}
typedef f32x4 AccT[2][2][4][2];

struct Params {
    const float* in[37];
    float* out; unsigned char* ws;
    int ph_lo, ph_hi;
};
enum { I_XP = 0, I_XS, I_S5RE, I_S5IM, I_MC, I_MN, I_MM, I_MCONV, I_META, I_F1N, I_F1G, I_F1U, I_F1D, I_MIXN, I_WIN, I_AR, I_AI, I_LDT, I_BR, I_BI, I_CR, I_CI, I_S5D, I_WGLU,
       I_CW, I_CB, I_MBI, I_MBF, I_MNORM, I_WBS, I_WBM, I_WOUT, I_F2N, I_F2G, I_F2U, I_F2D, I_FINN };

struct Frame {
    LAS unsigned char* lds;
    const Params* P;
    unsigned char* ws;
    int tid, lane, wave, G, bid;
};
DI const float* xrow(const Params& P, int r) {
    if (r < PROWS) { const int b = r / LP, t = r - b * LP; return t < 16 ? P.in[I_META] + (size_t)t * D : P.in[I_XP] + ((size_t)b * 2048 + (t - 16)) * D; }
    if (r < NTOK) return P.in[I_XS] + (size_t)(r - PROWS) * D;
    return nullptr;
}

struct EpiSwiglu {
    bf16_t* HID; const float* ssq;
    DI void operator()(const AccT& acc, const pg8::Unit& u, int wr, int wc, int fr, int fq) const {
        const int row0 = u.pm * 256 + wr * 64 + fr, col0 = u.pn * 128 + wc * 32 + 8 * fq;
        float rsv[8];
#pragma unroll
        for (int q = 0; q < 8; ++q) rsv[q] = ssq ? ssq[row0 + (q >> 2) * 128 + (q & 3) * 16] : 0.f;
#pragma unroll
        for (int ai = 0; ai < 2; ++ai)
#pragma unroll
            for (int m = 0; m < 4; ++m) {
                if (!((u.mask >> (ai * 2)) & 1)) continue;
                const int r = row0 + ai * 128 + m * 16;
                const float rs = ssq ? rsqrtf(rsv[ai * 4 + m] * (1.0f / D) + EPS) : 1.0f;
                float h[8];
#pragma unroll
                for (int n = 0; n < 2; ++n)
#pragma unroll
                    for (int j = 0; j < 4; ++j) h[n * 4 + j] = siluf_(acc[ai][0][m][n][j] * rs) * (acc[ai][1][m][n][j] * rs);
                u32x4 w; w.x = pk2(h[0], h[1]); w.y = pk2(h[2], h[3]); w.z = pk2(h[4], h[5]); w.w = pk2(h[6], h[7]);
                *(u32x4*)(HID + (size_t)r * DFF + col0) = w;
            }
    }
};
template <int MODE> struct EpiResid {
    const Params* P;
    DI void operator()(const AccT& acc, const pg8::Unit& u, int wr, int wc, int fr, int fq) const {
        const bool from_inputs = MODE == 0; const float scale = MODE == 1 ? 1.0f : 0.5f;
        float* const H = (float*)(P->ws + WS_H); float* const ssq = (float*)(P->ws + WS_SSQ) + MODE * MR;
        const float* const gain = MODE == 0 ? P->in[I_MIXN] : (MODE == 1 ? P->in[I_F2N] : nullptr); bf16_t* const Aout = MODE < 2 ? (bf16_t*)(P->ws + WS_XA) : nullptr;
        const int row0 = u.pm * 256 + wr * 64 + fr, col0 = u.pn * 256 + wc * 32 + 8 * fq;
        f32x4 gv[2][2];
#pragma unroll
        for (int bj = 0; bj < 2; ++bj) { gv[bj][0] = (f32x4){1.f, 1.f, 1.f, 1.f}; gv[bj][1] = gv[bj][0]; if (MODE < 2) { gv[bj][0] = *(const f32x4*)(gain + col0 + bj * 128); gv[bj][1] = *(const f32x4*)(gain + col0 + bj * 128 + 4); } }
#pragma unroll
        for (int ai = 0; ai < 2; ++ai) {
            if ((u.mask >> (ai * 2)) & 3) {
            f32x4 rv[4][2][2];
#pragma unroll
            for (int m = 0; m < 4; ++m) { const int r = row0 + ai * 128 + m * 16; const float* res = from_inputs ? xrow(*P, r) : H + (size_t)r * D;
#pragma unroll
                for (int bj = 0; bj < 2; ++bj) { rv[m][bj][0] = (f32x4){0.f, 0.f, 0.f, 0.f}; rv[m][bj][1] = rv[m][bj][0];
                    if (res && ((u.mask >> (ai * 2 + bj)) & 1)) { if (MODE == 1) { rv[m][bj][0] = __builtin_nontemporal_load((const f32x4*)(res + col0 + bj * 128)); rv[m][bj][1] = __builtin_nontemporal_load((const f32x4*)(res + col0 + bj * 128 + 4)); }
                        else { rv[m][bj][0] = *(const f32x4*)(res + col0 + bj * 128); rv[m][bj][1] = *(const f32x4*)(res + col0 + bj * 128 + 4); } } } }
#pragma unroll
            for (int m = 0; m < 4; ++m) {
                const int r = row0 + ai * 128 + m * 16;
                float ss = 0.f;
#pragma unroll
                for (int bj = 0; bj < 2; ++bj) {
                    if ((u.mask >> (ai * 2 + bj)) & 1) {
                    const int c = col0 + bj * 128;
                    const f32x4 v0 = rv[m][bj][0] + acc[ai][bj][m][0] * scale, v1 = rv[m][bj][1] + acc[ai][bj][m][1] * scale;
                    if (MODE == 1) { __builtin_nontemporal_store(v0, (f32x4*)(H + (size_t)r * D + c)); __builtin_nontemporal_store(v1, (f32x4*)(H + (size_t)r * D + c + 4)); }
                    else { *(f32x4*)(H + (size_t)r * D + c) = v0; *(f32x4*)(H + (size_t)r * D + c + 4) = v1; }
                    ss += (v0.x * v0.x + v0.y * v0.y) + (v0.z * v0.z + v0.w * v0.w) + (v1.x * v1.x + v1.y * v1.y) + (v1.z * v1.z + v1.w * v1.w);
                    if (MODE < 2) { const f32x4 g0 = gv[bj][0], g1 = gv[bj][1];
                        u32x4 w; w.x = pk2(v0.x * g0.x, v0.y * g0.y); w.y = pk2(v0.z * g0.z, v0.w * g0.w); w.z = pk2(v1.x * g1.x, v1.y * g1.y); w.w = pk2(v1.z * g1.z, v1.w * g1.w);
                        *(u32x4*)(Aout + (size_t)r * D + c) = w; }
                    }
                }
                ss += __shfl_xor(ss, 16); ss += __shfl_xor(ss, 32);
                if (fq == 0) atomicAdd(ssq + r, ss);
            } }
        }
    }
};
struct EpiWin {
    float* US5; float* QKPRE; bf16_t* V; bf16_t* SIGO; bf16_t* GATES; float* ZIF; const float* ssq;
    DI void operator()(const AccT& acc, const pg8::Unit& u, int wr, int wc, int fr, int fq) const {
        const int row0 = u.pm * 256 + wr * 64 + fr, pn = u.pn, cl = wc * 32 + 8 * fq;
        float rsv[8];
#pragma unroll
        for (int q = 0; q < 8; ++q) rsv[q] = ssq[row0 + (q >> 2) * 128 + (q & 3) * 16];
#pragma unroll
        for (int ai = 0; ai < 2; ++ai)
#pragma unroll
            for (int m = 0; m < 4; ++m) {
                const int r = row0 + ai * 128 + m * 16;
                const float rs = rsqrtf(rsv[ai * 4 + m] * (1.0f / D) + EPS);
#pragma unroll
                for (int bj = 0; bj < 2; ++bj) {
                    const int c = pn * 256 + bj * 128 + cl;
                    f32x4 v0 = acc[ai][bj][m][0] * rs, v1 = acc[ai][bj][m][1] * rs;
                    if (pn < 8) { float* dst = (pn < 4 ? US5 + (size_t)r * 1024 + c : QKPRE + (size_t)r * 1024 + (c - 1024)); *(f32x4*)dst = v0; *(f32x4*)(dst + 4) = v1; }
                    else if (pn < 32) {
                        if (pn >= 12) {
#pragma unroll
                            for (int j = 0; j < 4; ++j) { v0[j] = sigmoidf_(v0[j]); v1[j] = sigmoidf_(v1[j]); } }
                        u32x4 w; w.x = pk2(v0.x, v0.y); w.y = pk2(v0.z, v0.w); w.z = pk2(v1.x, v1.y); w.w = pk2(v1.z, v1.w);
                        bf16_t* dst = pn < 12 ? V + (size_t)r * 1024 + (c - 2048) : (pn < 16 ? SIGO + (size_t)r * 1024 + (c - 3072) : GATES + (size_t)r * 4096 + (c - 4096));
                        *(u32x4*)dst = w; }
                    else if (bj == 0 && cl == 0) { *(f32x4*)(ZIF + (size_t)r * 8) = v0; *(f32x4*)(ZIF + (size_t)r * 8 + 4) = v1; }
                }
            }
    }
};
struct EpiGlu {
    const bf16_t* YP; bf16_t* YO;
    DI void operator()(const AccT& acc, const pg8::Unit& u, int wr, int wc, int fr, int fq) const {
        const int row0 = u.pm * 256 + wr * 64 + fr, col0 = u.pn * 256 + wc * 32 + 8 * fq;
        u32x4 yv[8][2];
#pragma unroll
        for (int q = 0; q < 8; ++q)
#pragma unroll
            for (int bj = 0; bj < 2; ++bj) yv[q][bj] = *(const u32x4*)(YP + (size_t)(row0 + (q >> 2) * 128 + (q & 3) * 16) * 1024 + col0 + bj * 128);
#pragma unroll
        for (int ai = 0; ai < 2; ++ai)
#pragma unroll
            for (int m = 0; m < 4; ++m) {
                const int r = row0 + ai * 128 + m * 16;
#pragma unroll
                for (int bj = 0; bj < 2; ++bj) {
                    const size_t o = (size_t)r * 1024 + col0 + bj * 128;
                    const u32x4 y = yv[ai * 4 + m][bj]; const f32x4 a0 = acc[ai][bj][m][0], a1 = acc[ai][bj][m][1];
                    u32x4 w; w.x = pk2(bflo(y.x) * sigmoidf_(a0.x), bfhi(y.x) * sigmoidf_(a0.y)); w.y = pk2(bflo(y.y) * sigmoidf_(a0.z), bfhi(y.y) * sigmoidf_(a0.w));
                    w.z = pk2(bflo(y.z) * sigmoidf_(a1.x), bfhi(y.z) * sigmoidf_(a1.y)); w.w = pk2(bflo(y.w) * sigmoidf_(a1.z), bfhi(y.w) * sigmoidf_(a1.w));
                    *(u32x4*)(YO + o) = w; }
            }
    }
};
struct EpiBranch {
    const bf16_t* GATES; bf16_t* MG;
    DI void operator()(const AccT& acc, const pg8::Unit& u, int wr, int wc, int fr, int fq) const {
        const int row0 = u.pm * 256 + wr * 64 + fr, col0 = u.pn * 256 + wc * 32 + 8 * fq;
#pragma unroll
        for (int ai = 0; ai < 2; ++ai) {
            if ((u.mask >> (ai * 2)) & 3) {
            u32x4 gt[4][2], pv[4][2];
#pragma unroll
            for (int m = 0; m < 4; ++m)
#pragma unroll
                for (int bj = 0; bj < 2; ++bj) { const int r = row0 + ai * 128 + m * 16, c = col0 + bj * 128; gt[m][bj] = (u32x4){0u, 0u, 0u, 0u}; pv[m][bj] = gt[m][bj];
                    if ((u.mask >> (ai * 2 + bj)) & 1) { gt[m][bj] = __builtin_nontemporal_load((const u32x4*)(GATES + (size_t)r * 4096 + u.sub * 2048 + c)); if (u.sub) pv[m][bj] = *(const u32x4*)(MG + (size_t)r * D + c); } }
#pragma unroll
            for (int m = 0; m < 4; ++m) {
                const int r = row0 + ai * 128 + m * 16;
#pragma unroll
                for (int bj = 0; bj < 2; ++bj) {
                    if ((u.mask >> (ai * 2 + bj)) & 1) {
                    const int c = col0 + bj * 128;
                    const u32x4 g = gt[m][bj], p = pv[m][bj]; const f32x4 a0 = acc[ai][bj][m][0], a1 = acc[ai][bj][m][1];
                    float v[8] = {bflo(g.x) * a0.x, bfhi(g.x) * a0.y, bflo(g.y) * a0.z, bfhi(g.y) * a0.w, bflo(g.z) * a1.x, bfhi(g.z) * a1.y, bflo(g.w) * a1.z, bfhi(g.w) * a1.w};
                    if (u.sub) { v[0] += bflo(p.x); v[1] += bfhi(p.x); v[2] += bflo(p.y); v[3] += bfhi(p.y); v[4] += bflo(p.z); v[5] += bfhi(p.z); v[6] += bflo(p.w); v[7] += bfhi(p.w); }
                    u32x4 w; w.x = pk2(v[0], v[1]); w.y = pk2(v[2], v[3]); w.z = pk2(v[4], v[5]); w.w = pk2(v[6], v[7]);
                    *(u32x4*)(MG + (size_t)r * D + c) = w; } }
            } }
        }
    }
};

DI void tr_item(const float* W, int N, int srcn0, int nvalid, bf16_t* WT, int K, int dstrow0, int k0, LAS float* scr, int lane) {
    const int c4 = lane & 7, k8 = lane >> 3;
#pragma unroll
    for (int i = 0; i < 8; ++i) { const int kk = 8 * i + k8; f32x4 v = (f32x4){0.f, 0.f, 0.f, 0.f};
        if (4 * c4 < nvalid) v = __builtin_nontemporal_load((const f32x4*)(W + (size_t)(k0 + kk) * N + srcn0 + 4 * c4));
        LAS float* d = scr + kk * 33 + 4 * c4; d[0] = v.x; d[1] = v.y; d[2] = v.z; d[3] = v.w; }
    LDS_WAIT();
    const int c = lane & 7;
#pragma unroll
    for (int j = 0; j < 4; ++j) { const int n = (lane >> 3) + 8 * j; const LAS float* s = scr + (8 * c) * 33 + n;
        u32x4 o; o.x = pk2(s[0 * 33], s[1 * 33]); o.y = pk2(s[2 * 33], s[3 * 33]); o.z = pk2(s[4 * 33], s[5 * 33]); o.w = pk2(s[6 * 33], s[7 * 33]);
        *(u32x4*)(WT + (size_t)(dstrow0 + n) * K + k0 + 8 * c) = o; }
    LDS_WAIT();
}
constexpr int FFN_ITEMS_GU = 32 * 352, FFN_ITEMS_D = 88 * 64, FFN_ITEMS = FFN_ITEMS_GU + FFN_ITEMS_D;
DI void ffn_conv_item(const float* wg, const float* wu, const float* wd, bf16_t* dst, int it, LAS float* scr, int lane) {
    if (it < FFN_ITEMS_GU) { const int kb = it / 352, nb = it - kb * 352, d0 = nb * 32, tile = d0 >> 8, w = d0 & 255;
        tr_item(w < 128 ? wg : wu, DFF, tile * 128 + (w & 127), 32, dst, D, d0, kb * 64, scr, lane); }
    else { it -= FFN_ITEMS_GU; const int kb = it / 64, nb = it - kb * 64;
        tr_item(wd, D, nb * 32, 32, dst + (size_t)2 * DFF * D, DFF, nb * 32, kb * 64, scr, lane); }
}
DI void rms_row(Frame& F, int r, const float* gain, bf16_t* out) {
    const float* x = xrow(*F.P, r); u32x2* o = (u32x2*)(out + (size_t)r * D);
    if (!x) { for (int j = 0; j < 8; ++j) o[64 * j + F.lane] = (u32x2){0u, 0u}; return; }
    f32x4 v[8]; float s = 0.f;
#pragma unroll
    for (int j = 0; j < 8; ++j) { v[j] = ((const f32x4*)x)[64 * j + F.lane]; s += (v[j].x * v[j].x + v[j].y * v[j].y) + (v[j].z * v[j].z + v[j].w * v[j].w); }
    const float rs = rsqrtf(wave_sum(s) * (1.0f / D) + EPS);
#pragma unroll
    for (int j = 0; j < 8; ++j) { const f32x4 g = ((const f32x4*)gain)[64 * j + F.lane];
        o[64 * j + F.lane] = (u32x2){pk2(v[j].x * rs * g.x, v[j].y * rs * g.y), pk2(v[j].z * rs * g.z, v[j].w * rs * g.w)}; }
}
DI void s5_precompute(Frame& F, int g) {
    const Params& P = *F.P;
    LAS float* pw = (LAS float*)F.lds;
    LAS float* Bb = pw + 9 * 128;
    LAS float* Cc = Bb + 2048;
    LAS float* Kd = Cc + 2048;
    const int tid = F.tid;
    if (tid < 64) { const int p = tid;
        const float are = P.in[I_AR][g * 64 + p], aim = P.in[I_AI][g * 64 + p], dt = expf(P.in[I_LDT][g]);
        const float er = expf(are * dt), ang = aim * dt; const float ar = er * cosf(ang), ai = er * sinf(ang);
        float pr = 1.f, pi = 0.f;
        for (int d = 0; d <= 8; ++d) { pw[(d * 64 + p) * 2] = pr; pw[(d * 64 + p) * 2 + 1] = pi; const float nr = pr * ar - pi * ai, ni = pr * ai + pi * ar; pr = nr; pi = ni; }
        float* a8 = (float*)(F.ws + WS_A8) + (g * 64 + p) * 2; a8[0] = pw[(8 * 64 + p) * 2]; a8[1] = pw[(8 * 64 + p) * 2 + 1];
        const float nr = ar - 1.f, ni = ai, den = 1.0f / (are * are + aim * aim);
        const float cr = (nr * are + ni * aim) * den, ci = (ni * are - nr * aim) * den;
        for (int h = 0; h < 16; ++h) { const float br = P.in[I_BR][(g * 64 + p) * 16 + h], bi = P.in[I_BI][(g * 64 + p) * 16 + h];
            Bb[(p * 16 + h) * 2] = cr * br - ci * bi; Bb[(p * 16 + h) * 2 + 1] = cr * bi + ci * br; }
    }
    for (int e = tid; e < 1024; e += 512) { Cc[e * 2] = P.in[I_CR][g * 1024 + e]; Cc[e * 2 + 1] = P.in[I_CI][g * 1024 + e]; }
    __syncthreads();
    bf16_t* Em = (bf16_t*)(F.ws + WS_S5M) + (size_t)g * 3 * 16384; bf16_t* Mm = Em + 16384; bf16_t* Fm = Em + 32768;
    for (int e = tid; e < 2048; e += 512) { const int d = e >> 8, h = (e >> 4) & 15, h2 = e & 15; float s = 0.f;
        for (int p = 0; p < 64; ++p) { const float cr = Cc[(h * 64 + p) * 2], ci = Cc[(h * 64 + p) * 2 + 1], wr_ = pw[(d * 64 + p) * 2], wi = pw[(d * 64 + p) * 2 + 1];
            const float xr = cr * wr_ - ci * wi, xi = cr * wi + ci * wr_; s += xr * Bb[(p * 16 + h2) * 2] - xi * Bb[(p * 16 + h2) * 2 + 1]; }
        Kd[e] = s; }
    for (int e = tid; e < 16384; e += 512) { const int n = e >> 7, k = e & 127;
        { const int ri = n >> 6, p = n & 63, s = k >> 4, h2 = k & 15; const float wr_ = pw[((7 - s) * 64 + p) * 2], wi = pw[((7 - s) * 64 + p) * 2 + 1], br = Bb[(p * 16 + h2) * 2], bi = Bb[(p * 16 + h2) * 2 + 1];
          Em[e] = f2bf(ri ? wr_ * bi + wi * br : wr_ * br - wi * bi); }
        { const int t = n >> 4, h = n & 15, ri = k >> 6, p = k & 63; const float cr = Cc[(h * 64 + p) * 2], ci = Cc[(h * 64 + p) * 2 + 1], wr_ = pw[((t + 1) * 64 + p) * 2], wi = pw[((t + 1) * 64 + p) * 2 + 1];
          Fm[e] = f2bf(ri ? -(cr * wi + ci * wr_) : cr * wr_ - ci * wi); }
    }
    __syncthreads();
    for (int e = tid; e < 16384; e += 512) { const int n = e >> 7, k = e & 127, t = n >> 4, h = n & 15, s = k >> 4, h2 = k & 15;
        Mm[e] = f2bf(s <= t ? Kd[((t - s) * 16 + h) * 16 + h2] : 0.f); }
    __syncthreads();
}

DI int hsw(int r, int c) { return r * 128 + (c ^ ((r & 15) << 3)); }
constexpr int S5_UROW = 136;
DI void s5_item(Frame& F, int item) {
    const Params& P = *F.P;
    const bool samp = item >= 256; const int g = samp ? item - 256 : (item & 63), n = samp ? 0 : (item >> 6);
    const int npass = samp ? 1 : 2, prow = samp ? 128 : 129, nunits = samp ? 16 : 20, tokbase = samp ? PROWS : n * LP;
    LAS float* H = (LAS float*)F.lds;
    LAS bf16_t* U = (LAS bf16_t*)(F.lds + 160 * 512);
    const bf16_t* Em = (const bf16_t*)(F.ws + WS_S5M) + (size_t)g * 3 * 16384; const bf16_t* Mm = Em + 16384; const bf16_t* Fm = Em + 32768;
    const float* US5 = (const float*)(F.ws + WS_US5); bf16_t* YP = (bf16_t*)(F.ws + WS_YS5P);
    const int lane = F.lane, r31 = lane & 31, hh = lane >> 5;
    const float* a8p = (const float*)(F.ws + WS_A8) + (g * 64 + lane) * 2; const float ar = a8p[0], ai = a8p[1];
    float hr = 0.f, hi = 0.f;
#pragma unroll 1
    for (int pass = 0; pass < npass; ++pass) {
        const int tok0 = tokbase + pass * prow * 8;
        for (int e = F.tid; e < prow * 8 * 4; e += 512) { const int tk = e >> 2, q = e & 3; const f32x4 v = *(const f32x4*)(US5 + (size_t)(tok0 + tk) * 1024 + g * 16 + q * 4);
            *(LAS u32x2*)(U + (tk >> 3) * S5_UROW + (tk & 7) * 16 + q * 4) = (u32x2){pk2(v.x, v.y), pk2(v.z, v.w)}; }
        __syncthreads();
#pragma unroll 1
        for (int u = F.wave; u < nunits; u += 8) {
            const int rb = u >> 2, nb = u & 3, row = rb * 32 + r31; const bool valid = row < prow;
            bf16x8 bfr[8];
#pragma unroll
            for (int kb = 0; kb < 8; ++kb) bfr[kb] = *(const bf16x8*)(Em + (nb * 32 + r31) * 128 + kb * 16 + 8 * hh);
            f32x16 acc = zero16();
#pragma unroll
            for (int kb = 0; kb < 8; ++kb) { bf16x8 a = (bf16x8){0, 0, 0, 0, 0, 0, 0, 0}; if (valid) a = *(const LAS bf16x8*)(U + row * S5_UROW + kb * 16 + 8 * hh); acc = MFMA32(a, bfr[kb], acc); }
#pragma unroll
            for (int reg = 0; reg < 16; ++reg) H[hsw(rb * 32 + crow(reg, hh), nb * 32 + r31)] = acc[reg];
        }
        __syncthreads();
        if (samp) { for (int r = F.wave; r < 128; r += 8) { const size_t si = ((size_t)r * 64 + g) * 64 + lane; const float h0r = P.in[I_S5RE][si], h0i = P.in[I_S5IM][si];
                const float lr = H[hsw(r, lane)], li = H[hsw(r, 64 + lane)];
                P.out[O_SS5R + si] = ar * h0r - ai * h0i + lr; P.out[O_SS5I + si] = ar * h0i + ai * h0r + li; H[hsw(r, lane)] = h0r; H[hsw(r, 64 + lane)] = h0i; } }
        else if (F.wave == 0) {
#pragma unroll 1
            for (int j0 = 0; j0 < 136; j0 += 8) { float lr[8], li[8];
#pragma unroll
                for (int q = 0; q < 8; ++q) { const int j = j0 + q < 129 ? j0 + q : 128; lr[q] = H[hsw(j, lane)]; li[q] = H[hsw(j, 64 + lane)]; }
#pragma unroll
                for (int q = 0; q < 8; ++q) { if (j0 + q < 129) { H[hsw(j0 + q, lane)] = hr; H[hsw(j0 + q, 64 + lane)] = hi;
                    const float nr = ar * hr - ai * hi + lr[q], ni = ar * hi + ai * hr + li[q]; hr = nr; hi = ni; } } }
            if (pass == 1) { const size_t si = ((size_t)n * 64 + g) * 64 + lane; P.out[O_PS5R + si] = hr; P.out[O_PS5I + si] = hi; } }
        __syncthreads();
#pragma unroll 1
        for (int u = F.wave; u < nunits; u += 8) {
            const int rb = u >> 2, nb = u & 3, row = rb * 32 + r31; const bool valid = row < prow;
            const int col = nb * 32 + r31, t = col >> 4, ch = g * 16 + (col & 15); const float Dv = P.in[I_S5D][ch];
            bf16x8 mfr[8], ffr[8]; float uo[16];
#pragma unroll
            for (int kb = 0; kb < 8; ++kb) { mfr[kb] = *(const bf16x8*)(Mm + (nb * 32 + r31) * 128 + kb * 16 + 8 * hh); ffr[kb] = *(const bf16x8*)(Fm + (nb * 32 + r31) * 128 + kb * 16 + 8 * hh); }
#pragma unroll
            for (int reg = 0; reg < 16; ++reg) { const int rr = rb * 32 + crow(reg, hh); uo[reg] = rr < prow ? US5[(size_t)(tok0 + rr * 8 + t) * 1024 + ch] : 0.f; }
            f32x16 acc = zero16();
#pragma unroll
            for (int kb = 0; kb < 8; ++kb) { bf16x8 a = (bf16x8){0, 0, 0, 0, 0, 0, 0, 0}; if (valid) a = *(const LAS bf16x8*)(U + row * S5_UROW + kb * 16 + 8 * hh); acc = MFMA32(a, mfr[kb], acc); }
#pragma unroll
            for (int kb = 0; kb < 8; ++kb) { const LAS float* hp = H + row * 128 + (((kb * 2 + hh) ^ (row & 15)) << 3); acc = MFMA32(cvt_frag(*(const LAS f32x4*)hp, *(const LAS f32x4*)(hp + 4)), ffr[kb], acc); }
#pragma unroll
            for (int reg = 0; reg < 16; ++reg) { const int rr = rb * 32 + crow(reg, hh);
                if (rr < prow) YP[(size_t)(tok0 + rr * 8 + t) * 1024 + ch] = f2bf(gelu_tanh(acc[reg] + Dv * uo[reg])); }
        }
        __syncthreads();
    }
}

constexpr int VT_STRIDE = 72;
DI float log_sigmoid(float x) { return fminf(x, 0.f) - log1pf(expf(-fabsf(x))); }
DI float conv1(const Params& P, float xm3, float xm2, float xm1, float x0, int col) {
    const float* w = P.in[I_CW]; return siluf_(xm3 * w[col] + xm2 * w[1024 + col] + xm1 * w[2048 + col] + x0 * w[3072 + col] + P.in[I_CB][col]);
}
DI void mlstm_prep(Frame& F, int item) {
    const Params& P = *F.P;
    const int hd = item & 3, c = (item >> 2) % NCH, n = (item >> 2) / NCH;
    const int t0 = c == 0 ? 0 : 16 + 64 * (c - 1), L = c == 0 ? 16 : 64, R0 = n * LP + t0;
    LAS bf16_t* KT = (LAS bf16_t*)F.lds;
    LAS bf16_t* VT = KT + 128 * VT_STRIDE + F.wave * 32 * VT_STRIDE;
    LAS float* wsc = (LAS float*)(F.lds + (128 + 256) * VT_STRIDE * 2);
    const float* ZIF = (const float*)(F.ws + WS_ZIF); const float* QKPRE = (const float*)(F.ws + WS_QKPRE);
    bf16_t* QK = (bf16_t*)(F.ws + WS_QK); const bf16_t* V = (const bf16_t*)(F.ws + WS_HID) + (size_t)MR * 4096;
    const int lane = F.lane, tid = F.tid;
    if (F.wave == 0) { const bool valid = lane < L; const int R = R0 + lane;
        const float ig = valid ? ZIF[(size_t)R * 8 + hd] + P.in[I_MBI][hd] : 0.f;
        const float lf = valid ? log_sigmoid(ZIF[(size_t)R * 8 + 4 + hd] + P.in[I_MBF][hd]) : 0.f;
        float b = lf; for (int o = 1; o < 64; o <<= 1) { const float t = __shfl_up(b, o); if (lane >= o) b += t; }
        const float bL = __shfl(b, L - 1);
        const float a = valid ? bL - b + ig : -INFINITY; const float mloc = wave_max(a);
        wsc[lane] = valid ? __expf(a - mloc) : 0.f;
        if (valid) { ((float*)(F.ws + WS_GB))[(size_t)R * 4 + hd] = b; ((float*)(F.ws + WS_GI))[(size_t)R * 4 + hd] = ig; }
        if (lane == 0) { float* its = (float*)(F.ws + WS_ITS); its[item] = bL; its[NITEM + item] = mloc; }
    }
    __syncthreads();
    { const int ch = tid & 255, col = ch < 128 ? hd * 128 + ch : 512 + hd * 128 + (ch - 128), s0 = (tid >> 8) * 32;
      const float* cw = P.in[I_CW]; const float w0 = cw[col], w1 = cw[1024 + col], w2 = cw[2048 + col], w3 = cw[3072 + col], cb = P.in[I_CB][col];
#pragma unroll 1
      for (int sq = s0; sq < s0 + 32 && sq < L; sq += 16) {
          const float* xp = QKPRE + (size_t)(R0 + sq) * 1024 + col; bf16_t* qo = QK + (size_t)(R0 + sq) * 1024 + col;
          float x[19];
#pragma unroll
          for (int i = 0; i < 19; ++i) x[i] = (t0 + sq - 3 + i >= 0) ? xp[(i - 3) * 1024] : 0.f;
#pragma unroll
          for (int i = 0; i < 16; ++i) {
              float v = siluf_(x[i] * w0 + x[i + 1] * w1 + x[i + 2] * w2 + x[i + 3] * w3 + cb); if (ch < 128) v *= 0.08838834764831845f;
              qo[i * 1024] = f2bf(v);
              if (ch >= 128) KT[(ch - 128) * VT_STRIDE + sq + i] = f2bf(v * wsc[sq + i]); } } }
    { const bool valid = lane < L; const bf16_t* vp = V + (size_t)(R0 + lane) * 1024 + hd * 256 + F.wave * 32;
#pragma unroll
      for (int q = 0; q < 4; ++q) { u32x4 w = (u32x4){0u, 0u, 0u, 0u}; if (valid) w = *(const u32x4*)(vp + q * 8);
          const unsigned ww[4] = {w.x, w.y, w.z, w.w};
#pragma unroll
          for (int j = 0; j < 4; ++j) { VT[(q * 8 + 2 * j) * VT_STRIDE + lane] = (bf16_t)(ww[j] & 0xffffu); VT[(q * 8 + 2 * j + 1) * VT_STRIDE + lane] = (bf16_t)(ww[j] >> 16); } } }
    __syncthreads();
    { const int r31 = lane & 31, hh = lane >> 5, nks = c == 0 ? 1 : 4;
      float* DC = (float*)(F.ws + WS_WFF) + (size_t)item * 32768;
#pragma unroll 1
      for (int nb = 0; nb < 4; ++nb) { f32x16 acc = zero16();
          for (int ks = 0; ks < nks; ++ks) { const bf16x8 a = *(const LAS bf16x8*)(VT + r31 * VT_STRIDE + ks * 16 + 8 * hh), b = *(const LAS bf16x8*)(KT + (nb * 32 + r31) * VT_STRIDE + ks * 16 + 8 * hh); acc = MFMA32(a, b, acc); }
#pragma unroll
          for (int reg = 0; reg < 16; ++reg) DC[(F.wave * 32 + crow(reg, hh)) * 128 + nb * 32 + r31] = acc[reg]; }
      if (tid < 128) { float s = 0.f; for (int q = 0; q < L; ++q) s += bf1(KT[tid * VT_STRIDE + q]); ((float*)(F.ws + WS_DN))[item * 128 + tid] = s; } }
    __syncthreads();
}
DI void mlstm_scan(Frame& F) {
    const Params& P = *F.P;
    const float* its = (const float*)(F.ws + WS_ITS); float* m0s = (float*)(F.ws + WS_ITS) + 2 * NITEM;
    const float* DC = (const float*)(F.ws + WS_WFF); bf16_t* CJ = (bf16_t*)(F.ws + WS_XA);
    const int gid = F.bid * 512 + F.tid;
    if (gid < 16 * 8192) { const int chain = gid >> 13, e4 = gid & 8191, n = chain >> 2, hd = chain & 3;
        f32x4 C = (f32x4){0.f, 0.f, 0.f, 0.f}; float m0 = 0.f;
#pragma unroll 1
        for (int c0 = 0; c0 < NCH; c0 += 11) { f32x4 d[11];
#pragma unroll
            for (int j = 0; j < 11; ++j) d[j] = __builtin_nontemporal_load((const f32x4*)(DC + (size_t)((n * NCH + c0 + j) * 4 + hd) * 32768 + e4 * 4));
#pragma unroll
            for (int j = 0; j < 11; ++j) { const int item = (n * NCH + c0 + j) * 4 + hd;
                const float bL = its[item], ml = its[NITEM + item], mn = fmaxf(bL + m0, ml), dec = __expf(bL + m0 - mn), sc = __expf(ml - mn);
                *(u32x2*)(CJ + (size_t)item * 32768 + e4 * 4) = (u32x2){pk2(C.x, C.y), pk2(C.z, C.w)};
                C = C * dec + d[j] * sc; m0 = mn; } }
        *(f32x4*)(P.out + O_PC + (size_t)chain * 32768 + e4 * 4) = C; }
    if (F.bid == 255) { const int chain = F.tid >> 5, k4 = F.tid & 31, n = chain >> 2, hd = chain & 3;
        const float* DN = (const float*)(F.ws + WS_DN); float* NJ = (float*)(F.ws + WS_NJ);
        f32x4 C = (f32x4){0.f, 0.f, 0.f, 0.f}; float m0 = 0.f;
        for (int c = 0; c < NCH; ++c) { const int item = (n * NCH + c) * 4 + hd;
            const float bL = its[item], ml = its[NITEM + item], mn = fmaxf(bL + m0, ml), dec = __expf(bL + m0 - mn), sc = __expf(ml - mn);
            *(f32x4*)(NJ + item * 128 + k4 * 4) = C; if (k4 == 0) m0s[item] = m0;
            const f32x4 d = *(const f32x4*)(DN + item * 128 + k4 * 4);
            C = C * dec + d * sc; m0 = mn; }
        *(f32x4*)(P.out + O_PN + chain * 128 + k4 * 4) = C; if (k4 == 0) P.out[O_PM + chain] = m0; }
}
DI void out_xtile(const bf16x8 (&kf)[8], const bf16x8 (&qf)[8], int sb, int t, int L, float bmt, const LAS float* sm, const LAS bf16_t* VT, int r31, int hh, f32x16& acc1, float& den1) {
    f32x16 x = zero16();
#pragma unroll
    for (int ks = 0; ks < 8; ++ks) x = MFMA32(kf[ks], qf[ks], x);
#pragma unroll
    for (int reg = 0; reg < 16; ++reg) { const int s = sb * 32 + crow(reg, hh); const float w = (s <= t && s < L) ? __expf(sm[s] + bmt) : 0.f; x[reg] *= w; den1 += x[reg]; }
#pragma unroll
    for (int st = 0; st < 2; ++st) { u32x4 p; p.x = pk2(x[8 * st], x[8 * st + 1]); p.y = pk2(x[8 * st + 2], x[8 * st + 3]); p.z = pk2(x[8 * st + 4], x[8 * st + 5]); p.w = pk2(x[8 * st + 6], x[8 * st + 7]);
        const LAS bf16_t* vv = VT + r31 * VT_STRIDE + sb * 32 + 16 * st + 4 * hh; const u32x2 v0 = *(const LAS u32x2*)vv, v1 = *(const LAS u32x2*)(vv + 8);
        const u32x4 vb = (u32x4){v0.x, v0.y, v1.x, v1.y};
        acc1 = MFMA32(__builtin_bit_cast(bf16x8, p), __builtin_bit_cast(bf16x8, vb), acc1); }
}
constexpr int QS_ROW = 136;
DI void mlstm_out(Frame& F, int item) {
    const int hd = item & 3, c = (item >> 2) % NCH, n = (item >> 2) / NCH;
    const int t0 = c == 0 ? 0 : 16 + 64 * (c - 1), L = c == 0 ? 16 : 64, R0 = n * LP + t0, ntb = c == 0 ? 1 : 2;
    LAS bf16_t* Qs = (LAS bf16_t*)F.lds; LAS bf16_t* Ks = Qs + 64 * QS_ROW;
    LAS bf16_t* VT = Ks + 64 * QS_ROW + F.wave * 32 * VT_STRIDE;
    LAS float* sm = (LAS float*)(F.lds + (2 * 64 * QS_ROW + 256 * VT_STRIDE) * 2) + F.wave * 512;
    const bf16_t* QK = (const bf16_t*)(F.ws + WS_QK); const bf16_t* V = (const bf16_t*)(F.ws + WS_HID) + (size_t)MR * 4096;
    const bf16_t* CJ = (const bf16_t*)(F.ws + WS_XA) + (size_t)item * 32768; const float* NJ = (const float*)(F.ws + WS_NJ) + item * 128;
    float* HU = (float*)(F.ws + WS_US5);
    const int lane = F.lane, r31 = lane & 31, hh = lane >> 5, tid = F.tid;
    const bool valid = lane < L;
    const float m0 = ((const float*)(F.ws + WS_ITS))[2 * NITEM + item];
    bf16x8 cf[8];
#pragma unroll
    for (int ks = 0; ks < 8; ++ks) cf[ks] = *(const bf16x8*)(CJ + (F.wave * 32 + r31) * 128 + ks * 16 + 8 * hh);
#pragma unroll
    for (int i = 0; i < 2; ++i) { const int e = tid + i * 512, row = e >> 4, c16 = e & 15; const bf16_t* src = QK + (size_t)(R0 + row) * 1024 + hd * 128 + c16 * 8;
        const u32x4 q = *(const u32x4*)src, k = *(const u32x4*)(src + 512);
        *(LAS u32x4*)(Qs + row * QS_ROW + c16 * 8) = q; *(LAS u32x4*)(Ks + row * QS_ROW + c16 * 8) = k; }
    { const float b = valid ? ((const float*)(F.ws + WS_GB))[(size_t)(R0 + lane) * 4 + hd] : 0.f, ig = valid ? ((const float*)(F.ws + WS_GI))[(size_t)(R0 + lane) * 4 + hd] : 0.f;
      const float cs = valid ? ig - b : -INFINITY; float pm = cs;
      for (int o = 1; o < 64; o <<= 1) { const float t = __shfl_up(pm, o); if (lane >= o) pm = fmaxf(pm, t); }
      const float bm = -fmaxf(m0, pm);
      sm[lane] = cs; sm[64 + lane] = bm; sm[128 + lane] = __expf(m0 + bm); sm[448 + lane] = __expf(bm - b); sm[256 + lane] = NJ[lane]; sm[320 + lane] = NJ[64 + lane]; }
#pragma unroll
    for (int i = 0; i < 4; ++i) { const int s = 16 * i + (lane >> 2), v8 = (lane & 3) * 8; u32x4 w = (u32x4){0u, 0u, 0u, 0u};
        if (s < L) w = *(const u32x4*)(V + (size_t)(R0 + s) * 1024 + hd * 256 + F.wave * 32 + v8);
        const unsigned ww[4] = {w.x, w.y, w.z, w.w};
#pragma unroll
        for (int j = 0; j < 4; ++j) { VT[(v8 + 2 * j) * VT_STRIDE + s] = (bf16_t)(ww[j] & 0xffffu); VT[(v8 + 2 * j + 1) * VT_STRIDE + s] = (bf16_t)(ww[j] >> 16); } }
    __syncthreads();
#pragma unroll
    for (int tb = 0; tb < 2; ++tb) { if (tb < ntb) {
        const int t = tb * 32 + r31; const float bmt = sm[64 + t];
        bf16x8 qf[8];
#pragma unroll
        for (int ks = 0; ks < 8; ++ks) qf[ks] = *(const LAS bf16x8*)(Qs + t * QS_ROW + ks * 16 + 8 * hh);
        float den2 = 0.f;
#pragma unroll
        for (int ks = 0; ks < 8; ++ks) { const u32x4 w = __builtin_bit_cast(u32x4, qf[ks]); const LAS float* nn = sm + 256 + ks * 16 + 8 * hh;
            den2 += bflo(w.x) * nn[0] + bfhi(w.x) * nn[1] + bflo(w.y) * nn[2] + bfhi(w.y) * nn[3] + bflo(w.z) * nn[4] + bfhi(w.z) * nn[5] + bflo(w.w) * nn[6] + bfhi(w.w) * nn[7]; }
        den2 += __shfl_xor(den2, 32);
        f32x16 acc1 = zero16(), acc2 = zero16(); float den1 = 0.f;
#pragma unroll
        for (int sb = 0; sb < 2; ++sb) { if (sb <= tb) {
            bf16x8 kf[8];
#pragma unroll
            for (int ks = 0; ks < 8; ++ks) kf[ks] = *(const LAS bf16x8*)(Ks + (sb * 32 + r31) * QS_ROW + ks * 16 + 8 * hh);
            out_xtile(kf, qf, sb, t, L, bmt, sm, VT, r31, hh, acc1, den1); } }
#pragma unroll
        for (int ks = 0; ks < 8; ++ks) acc2 = MFMA32(qf[ks], cf[ks], acc2);
        den1 += __shfl_xor(den1, 32);
        { const float den = den1 + sm[128 + t] * den2; if (hh == 0) sm[192 + t] = 1.0f / fmaxf(fabsf(den), sm[448 + t]); }
        LDS_WAIT();
#pragma unroll
        for (int reg = 0; reg < 16; ++reg) { const int tt = tb * 32 + crow(reg, hh);
            if (tt < L) HU[(size_t)(R0 + tt) * 1024 + hd * 256 + F.wave * 32 + r31] = (acc1[reg] + sm[128 + tt] * acc2[reg]) * sm[192 + tt]; }
    } }
    __syncthreads();
}
DI void mlstm_sample(Frame& F, int chain) {
    const Params& P = *F.P;
    const int n = chain >> 2, hd = chain & 3, R0 = PROWS + n * 8;
    LAS float* qs = (LAS float*)F.lds;
    LAS float* ks = qs + 1024;
    LAS float* vs = ks + 1024;
    LAS float* ss = vs + 2048;
    LAS float* ga = ss + 64;
    const float* ZIF = (const float*)(F.ws + WS_ZIF); const float* QKPRE = (const float*)(F.ws + WS_QKPRE);
    const bf16_t* V = (const bf16_t*)(F.ws + WS_HID) + (size_t)MR * 4096; float* HU = (float*)(F.ws + WS_US5);
    const int tid = F.tid, lane = F.lane;
    const float m0 = P.in[I_MM][chain];
    if (F.wave == 0) { const bool valid = lane < 8; const int R = R0 + lane;
        const float ig = valid ? ZIF[(size_t)R * 8 + hd] + P.in[I_MBI][hd] : 0.f;
        const float lf = valid ? log_sigmoid(ZIF[(size_t)R * 8 + 4 + hd] + P.in[I_MBF][hd]) : 0.f;
        float b = lf; for (int o = 1; o < 64; o <<= 1) { const float t = __shfl_up(b, o); if (lane >= o) b += t; }
        const float cs = valid ? ig - b : -INFINITY; float pm = cs;
        for (int o = 1; o < 64; o <<= 1) { const float t = __shfl_up(pm, o); if (lane >= o) pm = fmaxf(pm, t); }
        const float bm = -fmaxf(m0, pm), mt = b - bm;
        const float bL = __shfl(b, 7), mnew = __shfl(mt, 7);
        if (valid) { ga[lane] = __expf(bL - b + ig - mnew); ga[8 + lane] = cs; ga[16 + lane] = bm; ga[24 + lane] = __expf(m0 + bm); ga[32 + lane] = __expf(-mt); }
        if (lane == 0) { ga[56] = __expf(bL + m0 - mnew); P.out[O_SM + chain] = mnew; }
    }
    for (int e = tid; e < 2048; e += 512) { const int s = e >> 8, ch = e & 255, col = ch < 128 ? hd * 128 + ch : 512 + hd * 128 + (ch - 128);
        float x[4];
#pragma unroll
        for (int j = 0; j < 4; ++j) { const int t = s - 3 + j; x[j] = t >= 0 ? QKPRE[(size_t)(R0 + t) * 1024 + col] : P.in[I_MCONV][((size_t)n * 3 + (3 + t)) * 1024 + col]; }
        const float v = conv1(P, x[0], x[1], x[2], x[3], col);
        if (ch < 128) qs[s * 128 + ch] = v * 0.08838834764831845f; else ks[s * 128 + ch - 128] = v; }
    for (int e = tid; e < 2048; e += 512) { const int s = e >> 8, v = e & 255; vs[e] = bf1(V[(size_t)(R0 + s) * 1024 + hd * 256 + v]); }
    __syncthreads();
    if (F.wave == 0) { const int t = lane >> 3, s = lane & 7; float d = 0.f;
        if (s <= t) { for (int k = 0; k < 128; ++k) d += qs[t * 128 + k] * ks[s * 128 + k]; d *= __expf(ga[8 + s] + ga[16 + t]); }
        ss[lane] = d; }
    else if (F.wave == 1) { const int t = lane >> 3, part = lane & 7; float d = 0.f;
        for (int k = part * 16; k < part * 16 + 16; ++k) d += P.in[I_MN][chain * 128 + k] * qs[t * 128 + k];
        d += __shfl_xor(d, 1); d += __shfl_xor(d, 2); d += __shfl_xor(d, 4); if (part == 0) ga[40 + t] = d; }
    __syncthreads();
    if (tid < 8) { float den = 0.f; for (int s = 0; s < 8; ++s) den += ss[tid * 8 + s]; den += ga[24 + tid] * ga[40 + tid]; ga[48 + tid] = 1.0f / fmaxf(fabsf(den), ga[32 + tid]); }
    __syncthreads();
    { const float decay = ga[56];
      const float* C0 = P.in[I_MC] + (size_t)chain * 32768; float* Cn = P.out + O_SC + (size_t)chain * 32768;
      { const int r31 = lane & 31, hh = lane >> 5; f32x16 acc = zero16();
        f32x4 ca[8], cb[8];
#pragma unroll
        for (int kq = 0; kq < 8; ++kq) { const float* cp = C0 + (F.wave * 32 + r31) * 128 + kq * 16 + 8 * hh; ca[kq] = *(const f32x4*)cp; cb[kq] = *(const f32x4*)(cp + 4); }
#pragma unroll
        for (int kq = 0; kq < 8; ++kq) { f32x4 qa = (f32x4){0.f, 0.f, 0.f, 0.f}, qb = qa;
            if (r31 < 8) { const LAS float* qp = qs + r31 * 128 + kq * 16 + 8 * hh; qa = *(const LAS f32x4*)qp; qb = *(const LAS f32x4*)(qp + 4); }
            acc = MFMA32(cvt_frag(ca[kq], cb[kq]), cvt_frag(qa, qb), acc); }
        if (r31 < 8) { const int t = r31; const float it = ga[24 + t], iv = ga[48 + t];
#pragma unroll
            for (int reg = 0; reg < 16; ++reg) { const int v = F.wave * 32 + crow(reg, hh); float sv = 0.f;
#pragma unroll
                for (int s = 0; s < 8; ++s) sv += ss[t * 8 + s] * vs[s * 256 + v];
                HU[(size_t)(R0 + t) * 1024 + hd * 256 + v] = (sv + it * acc[reg]) * iv; } } }
      { const int k4 = tid & 31, vr = tid >> 5;
        f32x4 kr[8];
#pragma unroll
        for (int t = 0; t < 8; ++t) kr[t] = *(const LAS f32x4*)(ks + t * 128 + k4 * 4);
#pragma unroll 1
        for (int p0 = 0; p0 < 16; p0 += 4) { f32x4 c0s[4];
#pragma unroll
            for (int q = 0; q < 4; ++q) c0s[q] = __builtin_nontemporal_load((const f32x4*)(C0 + ((p0 + q) * 16 + vr) * 128 + k4 * 4));
#pragma unroll
            for (int q = 0; q < 4; ++q) { const int v = (p0 + q) * 16 + vr; f32x4 cn = c0s[q] * decay;
#pragma unroll
                for (int s = 0; s < 8; ++s) cn += kr[s] * (ga[s] * vs[s * 256 + v]);
                __builtin_nontemporal_store(cn, (f32x4*)(Cn + v * 128 + k4 * 4)); } } }
      if (tid < 128) { float nn = decay * P.in[I_MN][chain * 128 + tid]; for (int s = 0; s < 8; ++s) nn += ga[s] * ks[s * 128 + tid]; P.out[O_SN + chain * 128 + tid] = nn; } }
    __syncthreads();
}
DI void yml_row(Frame& F, int r) {
    const float* HU = (const float*)(F.ws + WS_US5) + (size_t)r * 1024; const bf16_t* SG = (const bf16_t*)(F.ws + WS_SIGO) + (size_t)r * 1024;
    u32x2* o = (u32x2*)((bf16_t*)(F.ws + WS_QKPRE) + (size_t)r * 1024);
    if (r >= NTOK) { for (int j = 0; j < 4; ++j) o[64 * j + F.lane] = (u32x2){0u, 0u}; return; }
#pragma unroll
    for (int j = 0; j < 4; ++j) { const f32x4 v = __builtin_nontemporal_load((const f32x4*)HU + 64 * j + F.lane); const float s = wave_sum((v.x * v.x + v.y * v.y) + (v.z * v.z + v.w * v.w));
        const float rn = rsqrtf(s * (1.0f / 256.0f) + EPS); const f32x4 g = ((const f32x4*)F.P->in[I_MNORM])[64 * j + F.lane]; const u32x2 sg = __builtin_nontemporal_load((const u32x2*)SG + 64 * j + F.lane);
        o[64 * j + F.lane] = (u32x2){pk2(v.x * rn * g.x * bflo(sg.x), v.y * rn * g.y * bfhi(sg.x)), pk2(v.z * rn * g.z * bflo(sg.y), v.w * rn * g.w * bfhi(sg.y))}; }
}


DI int grab_item(Frame& F, unsigned* cnt) {
    volatile LAS int* slot = (volatile LAS int*)(F.lds + 288 * 512 + 768);
    if (F.tid == 0) *slot = (int)__hip_atomic_fetch_add(cnt, 1u, __ATOMIC_RELAXED, __HIP_MEMORY_SCOPE_AGENT);
    __syncthreads();
    const int v = *slot;
    __syncthreads();
    return v;
}

#define XB_TMO      128
#define XB_XCNT(j)  (256  + 64 * (j))
#define XB_XSUB(j)  (1280 + 64 * (j))
#define XB_XGEN(j)  (2304 + 64 * (j))
#define XB_TOP      3328
#define XB_TOPGEN   3392
#define XCD_BAR_WORDS 3456
#define XB_SPIN_CAP (1u << 22)
DI unsigned xb_ld(unsigned* p)              { return __hip_atomic_load(p, __ATOMIC_RELAXED, __HIP_MEMORY_SCOPE_AGENT); }
DI unsigned xb_add(unsigned* p, unsigned v) { return __hip_atomic_fetch_add(p, v, __ATOMIC_RELAXED, __HIP_MEMORY_SCOPE_AGENT); }
DI unsigned xb_xcc_id() { return (unsigned)__builtin_amdgcn_s_getreg((3 << 11) | 20) & 0xFu; }
#define XB_SPIN(cond, bar) do { unsigned _sp = 0; while (cond) { __builtin_amdgcn_s_sleep(1); \
    if ((++_sp & 255u) == 0u) { if (xb_ld(&(bar)[XB_TMO])) break; if (_sp > XB_SPIN_CAP) { atomicAdd(&(bar)[XB_TMO], 1u); break; } } } } while (0)
struct XcdBarrier { unsigned* bar; unsigned x; volatile LAS unsigned* st; };
DI XcdBarrier xcd_barrier_post(unsigned* bar, volatile LAS unsigned* st) {
    XcdBarrier b; b.bar = bar; b.x = xb_xcc_id(); b.st = st;
    if (threadIdx.x == 0) (void)xb_add(&bar[XB_XCNT(b.x)], 1u);
    return b;
}
DI void xcd_barrier_complete(unsigned* bar, unsigned x, unsigned& nloc, unsigned& nx) {
    const unsigned G = gridDim.x * gridDim.y * gridDim.z;
    unsigned sum, cnt, mine, sp = 0u;
    for (;;) {
        sum = 0u; cnt = 0u; mine = 0u;
#pragma unroll
        for (unsigned j = 0; j < 16; ++j) { const unsigned c = xb_ld(&bar[XB_XCNT(j)]); sum += c; cnt += (c > 0u) ? 1u : 0u; mine = (j == x) ? c : mine; }
        if (sum == G) break;
        __builtin_amdgcn_s_sleep(1);
        if ((++sp & 255u) == 0u) { if (xb_ld(&bar[XB_TMO])) break; if (sp > XB_SPIN_CAP) { atomicAdd(&bar[XB_TMO], 1u); break; } }
    }
    nloc = mine > 0u ? mine : 1u; nx = cnt > 0u ? cnt : 1u;
}
DI void xcd_barrier(const XcdBarrier& b) {
    asm volatile("s_waitcnt vmcnt(0)" ::: "memory");
    __syncthreads();
    if (threadIdx.x == 0) {
        unsigned* bar = b.bar;
        __builtin_amdgcn_s_waitcnt(0);
        unsigned nloc = b.st[0], nx = b.st[1];
        if (nloc == 0u) { xcd_barrier_complete(bar, b.x, nloc, nx); b.st[0] = nloc; b.st[1] = nx; }
        const unsigned old = xb_add(&bar[XB_XSUB(b.x)], 1u);
        const unsigned gen = old / nloc;
        if (old + 1u == (gen + 1u) * nloc) {
            __builtin_amdgcn_fence(__ATOMIC_RELEASE, "agent");
            asm volatile("s_waitcnt vmcnt(0)" ::: "memory");
            const unsigned og = xb_add(&bar[XB_TOP], 1u);
            const unsigned tg = og / nx;
            if (og + 1u == (tg + 1u) * nx) xb_add(&bar[XB_TOPGEN], 1u);
            else XB_SPIN(xb_ld(&bar[XB_TOPGEN]) == tg, bar);
            __builtin_amdgcn_fence(__ATOMIC_ACQUIRE, "agent");
            xb_add(&bar[XB_XGEN(b.x)], 1u);
            asm volatile("s_waitcnt vmcnt(0)" ::: "memory");
        } else {
            XB_SPIN(xb_ld(&bar[XB_XGEN(b.x)]) == gen, bar);
            __builtin_amdgcn_fence(__ATOMIC_ACQUIRE, "agent");
            asm volatile("s_waitcnt vmcnt(0)" ::: "memory");
        }
    }
    __syncthreads();
}

__global__ void __launch_bounds__(512, 2) fwd_kernel(Params prm) {
    extern __shared__ __attribute__((aligned(16))) unsigned char lds_raw[];
    cg::grid_group grid = cg::this_grid();
    Frame F; F.lds = (LAS unsigned char*)lds_raw; F.P = &prm; F.ws = prm.ws; F.tid = threadIdx.x; F.lane = F.tid & 63; F.wave = __builtin_amdgcn_readfirstlane(F.tid >> 6); F.G = gridDim.x; F.bid = blockIdx.x;
    const Params& P = prm;
    unsigned char* ws = prm.ws;
    const int gw = F.bid * 8 + F.wave, NGW = F.G * 8;
    const int lo = prm.ph_lo, hi = prm.ph_hi;
#define IN(k) (lo <= (k) && (k) < hi)
#define SEAM(k) do { if (IN(k) && IN((k) + 1)) { xcd_barrier(xbar); } } while (0)
    volatile LAS unsigned* xst = (volatile LAS unsigned*)(F.lds + 288 * 512 + 512);
    if (F.tid < 2) xst[F.tid] = 0u;
    __syncthreads();
    XcdBarrier xbar; xbar.bar = (unsigned*)(ws + WS_BAR); xbar.x = 0; xbar.st = xst;
    if (hi - lo > 1) xbar = xcd_barrier_post((unsigned*)(ws + WS_BAR), xst);
    if (lo > 4096) grid.sync();
#ifndef DUP_MASK
#define DUP_MASK 0
#endif
#define PH(k) for (int rep_ = 0; rep_ < (IN(k) ? 1 + ((DUP_MASK >> (k)) & 1) : 0); ++rep_)
    bf16_t* W1 = (bf16_t*)(ws + WS_WFF); bf16_t* XA = (bf16_t*)(ws + WS_XA); bf16_t* HID = (bf16_t*)(ws + WS_HID); float* H = (float*)(ws + WS_H);
    float* SSQ = (float*)(ws + WS_SSQ);

    PH(0) {
        LAS float* scr = (LAS float*)(F.lds + F.wave * 8704);
        for (int i = F.bid * 512 + F.tid; i < 3 * MR; i += F.G * 512) SSQ[i] = 0.f;
        if (F.bid == 0 && F.tid < 4) ((unsigned*)(ws + WS_CNT))[F.tid * 64] = 0u;
        for (int i = F.bid * 512 + F.tid; i < (MR - NTOK) * 1024 / 2; i += F.G * 512) ((unsigned*)((bf16_t*)(ws + WS_YS5P) + (size_t)NTOK * 1024))[i] = 0u;
        for (int it = gw; it < 32 * 264; it += NGW) { const int kb = it / 264, nb = it - kb * 264, d0 = nb * 32;
            int src = d0, nv = 32; if (d0 >= 8192) { src = 4096; nv = d0 == 8192 ? 8 : 0; } else if (d0 >= 4096) src = d0 + 8;
            tr_item(P.in[I_WIN], 8200, src, nv, (bf16_t*)(ws + WS_WIN), D, d0, kb * 64, scr, F.lane); }
        for (int it = gw; it < 16 * 32; it += NGW) { const int kb = it / 32, nb = it - kb * 32; tr_item(P.in[I_WGLU], 1024, nb * 32, 32, (bf16_t*)(ws + WS_WGLU), 1024, nb * 32, kb * 64, scr, F.lane); }
        for (int it = gw; it < 16 * 64; it += NGW) { const int kb = it / 64, nb = it - kb * 64; tr_item(P.in[I_WBS], 2048, nb * 32, 32, (bf16_t*)(ws + WS_WBS), 1024, nb * 32, kb * 64, scr, F.lane);
            tr_item(P.in[I_WBM], 2048, nb * 32, 32, (bf16_t*)(ws + WS_WBM), 1024, nb * 32, kb * 64, scr, F.lane); }
        for (int it = gw; it < 32 * 64; it += NGW) { const int kb = it / 64, nb = it - kb * 64; tr_item(P.in[I_WOUT], 2048, nb * 32, 32, (bf16_t*)(ws + WS_WOUT), 2048, nb * 32, kb * 64, scr, F.lane); }
        for (int it = gw; it < FFN_ITEMS; it += NGW) ffn_conv_item(P.in[I_F1G], P.in[I_F1U], P.in[I_F1D], W1, FFN_ITEMS - 1 - it, scr, F.lane);
        for (int r = gw; r < MR; r += NGW) rms_row(F, r, P.in[I_F1N], XA);
        __syncthreads();
        if (F.bid >= 192) s5_precompute(F, F.bid - 192);
    }
    SEAM(0);
    PH(1) { pg8::Gemm g{XA, XA, W1, W1, D}; pg8::Order S; S.init(MR, 2 * DFF, F.G, F.bid, 1, 2); EpiSwiglu E{HID, nullptr}; pg8::gemm_phase(F.lds, g, S, E); }
    SEAM(1);
    PH(2) { pg8::Gemm g{HID, HID, W1 + (size_t)2 * DFF * D, W1 + (size_t)2 * DFF * D, DFF}; pg8::Order S; S.init(MR, D, F.G, F.bid, 1, 4);
        EpiResid<0> E{&prm}; pg8::gemm_phase(F.lds, g, S, E); }
    SEAM(2);
    PH(3) { const bf16_t* W = (const bf16_t*)(ws + WS_WIN); pg8::Gemm g{XA, XA, W, W, D}; pg8::Order S; S.init(MR, NIN, F.G, F.bid, 1, 1);
        EpiWin E{(float*)(ws + WS_US5), (float*)(ws + WS_QKPRE), HID + (size_t)MR * 4096, (bf16_t*)(ws + WS_SIGO), HID, (float*)(ws + WS_ZIF), SSQ}; pg8::gemm_phase(F.lds, g, S, E); }
    SEAM(3);
    PH(4) {
        for (;;) { const int it = grab_item(F, (unsigned*)(ws + WS_CNT)); if (it >= NITEM + 320) break; if (it < 320) s5_item(F, it); else mlstm_prep(F, it - 320); }
        const float* QKPRE = (const float*)(ws + WS_QKPRE);
        for (int i = F.bid * 512 + F.tid; i < (NB + NS) * 3 * 1024; i += F.G * 512) { const int col = i & 1023, rr = i >> 10, j = rr % 3, b = rr / 3;
            if (b < NB) P.out[O_PCONV + ((size_t)b * 3 + j) * 1024 + col] = QKPRE[(size_t)(b * LP + LP - 3 + j) * 1024 + col];
            else P.out[O_SCONV + ((size_t)(b - NB) * 3 + j) * 1024 + col] = QKPRE[(size_t)(PROWS + (b - NB) * 8 + 5 + j) * 1024 + col]; }
    }
    SEAM(4);
    PH(5) mlstm_scan(F);
    SEAM(5);
    PH(6) {
        for (;;) { const int it = grab_item(F, (unsigned*)(ws + WS_CNT) + 64); if (it >= NITEM + NS * 4) break;
            if (it < NITEM) mlstm_out(F, it); else mlstm_sample(F, it - NITEM); }
        { LAS float* scr = (LAS float*)(F.lds + F.wave * 8704);
          for (;;) { const int it = grab_item(F, (unsigned*)(ws + WS_CNT) + 128); if (it >= FFN_ITEMS / 8) break;
              ffn_conv_item(P.in[I_F2G], P.in[I_F2U], P.in[I_F2D], W1, it * 8 + F.wave, scr, F.lane); } }
    }
    SEAM(6);
    PH(7) {
        bf16_t* YML = (bf16_t*)(ws + WS_QKPRE); bf16_t* YS5 = YML + (size_t)MR * 1024;
        const bf16_t* W = (const bf16_t*)(ws + WS_WGLU); const bf16_t* YP = (const bf16_t*)(ws + WS_YS5P);
        pg8::Gemm g{YP, YP, W, W, 1024}; pg8::Order S; S.init(MR, 1024, F.G, F.bid, 1, 1); EpiGlu E{YP, YS5}; pg8::gemm_phase(F.lds, g, S, E);
        const int nidle = F.G - 148;
        if (F.bid >= 148) for (int r = (F.bid - 148) * 8 + F.wave; r < MR; r += nidle * 8) yml_row(F, r);
    }
    SEAM(7);
    PH(8) { const bf16_t* YML = (const bf16_t*)(ws + WS_QKPRE); const bf16_t* YS5 = YML + (size_t)MR * 1024;
        pg8::Gemm g{YS5, YML, (const bf16_t*)(ws + WS_WBS), (const bf16_t*)(ws + WS_WBM), 1024}; pg8::Order S; S.init(MR, D, F.G, F.bid, 2, 4);
        EpiBranch E{HID, (bf16_t*)(ws + WS_US5)}; pg8::gemm_phase(F.lds, g, S, E); }
    SEAM(8);
    PH(9) { const bf16_t* MG = (const bf16_t*)(ws + WS_US5); const bf16_t* W = (const bf16_t*)(ws + WS_WOUT); pg8::Gemm g{MG, MG, W, W, D}; pg8::Order S; S.init(MR, D, F.G, F.bid, 1, 4);
        EpiResid<1> E{&prm}; pg8::gemm_phase(F.lds, g, S, E); }
    SEAM(9);
    PH(10) { pg8::Gemm g{XA, XA, W1, W1, D}; pg8::Order S; S.init(MR, 2 * DFF, F.G, F.bid, 1, 2); EpiSwiglu E{HID, SSQ + MR}; pg8::gemm_phase(F.lds, g, S, E); }
    SEAM(10);
    PH(11) { pg8::Gemm g{HID, HID, W1 + (size_t)2 * DFF * D, W1 + (size_t)2 * DFF * D, DFF}; pg8::Order S; S.init(MR, D, F.G, F.bid, 1, 4);
        EpiResid<2> E{&prm}; pg8::gemm_phase(F.lds, g, S, E); }
    SEAM(11);
    PH(12) {
        for (int r = gw; r < NTOK; r += NGW) { float* o;
            if (r < PROWS) { const int b = r / LP, t = r - b * LP; if (t < 16) continue; o = P.out + O_YP + ((size_t)b * 2048 + (t - 16)) * D; } else o = P.out + O_YS + (size_t)(r - PROWS) * D;
            const float rs = rsqrtf(SSQ[2 * MR + r] * (1.0f / D) + EPS); const f32x4* h = (const f32x4*)(H + (size_t)r * D); const f32x4* gn = (const f32x4*)P.in[I_FINN];
#pragma unroll
            for (int j = 0; j < 8; ++j) __builtin_nontemporal_store(__builtin_nontemporal_load(h + 64 * j + F.lane) * rs * gn[64 * j + F.lane], (f32x4*)o + 64 * j + F.lane); }
    }
#undef IN
#undef SEAM
}

#ifndef N_LAUNCH_SPLIT
#define N_LAUNCH_SPLIT 0
#endif
#ifndef LAUNCH_LIST
#define LAUNCH_LIST {0, 1, 2, 3, 4, 5, 6, 7, 8, 9, 10, 11, 12}
#endif
extern "C" void kernel_launch(void* const* d_in, const int* in_sizes, int n_in, void* d_out, int out_size, void* d_ws, size_t ws_size, hipStream_t stream) {
    static int grid = 0;
    if (grid == 0) {
        if (n_in != 37 || (size_t)out_size != O_END || ws_size < WS_END) { fprintf(stderr, "kernel_launch: unexpected shapes (n_in %d, out %d, ws %zu, need %zu)\n", n_in, out_size, ws_size, (size_t)WS_END); grid = -1; return; }
        int dev = 0, cus = 0, per_cu = 0;
        hipGetDevice(&dev); hipDeviceGetAttribute(&cus, hipDeviceAttributeMultiprocessorCount, dev);
        if (hipFuncSetAttribute((const void*)fwd_kernel, hipFuncAttributeMaxDynamicSharedMemorySize, LDS_BYTES) != hipSuccess) { fprintf(stderr, "kernel_launch: hipFuncSetAttribute failed\n"); grid = -1; return; }
        if (hipOccupancyMaxActiveBlocksPerMultiprocessor(&per_cu, (const void*)fwd_kernel, 512, LDS_BYTES) != hipSuccess || per_cu < 1) per_cu = 1;
        (void)hipGetLastError();
        grid = cus;
    }
    if (grid < 0) return;
    Params p{};
    for (int i = 0; i < 37; ++i) p.in[i] = (const float*)d_in[i];
    p.out = (float*)d_out; p.ws = (unsigned char*)d_ws;
#if N_LAUNCH_SPLIT
    { const int plist[] = LAUNCH_LIST; for (int k : plist) { p.ph_lo = k; p.ph_hi = k + 1; hipLaunchKernelGGL(fwd_kernel, dim3(grid), dim3(512), LDS_BYTES, stream, p); } }
#else
    p.ph_lo = 0; p.ph_hi = 13;
    (void)hipMemsetAsync((char*)d_ws + WS_BAR, 0, 16384, stream);
    void* args[] = {&p};
    hipError_t e = hipLaunchCooperativeKernel((const void*)fwd_kernel, dim3(grid), dim3(512), args, LDS_BYTES, stream);
    if (e != hipSuccess) fprintf(stderr, "cooperative launch failed: %s (grid %d)\n", hipGetErrorString(e), grid);
#endif
}
```

```cpp
#include <hip/hip_runtime.h>
#include <hip/hip_cooperative_groups.h>
#include <cstdio>
#include <cstdint>
namespace cg = cooperative_groups;

#define LAS __attribute__((address_space(3)))
typedef unsigned short bf16_t;
typedef short bf16x8 __attribute__((ext_vector_type(8)));
typedef float f32x2 __attribute__((ext_vector_type(2)));
typedef float f32x4 __attribute__((ext_vector_type(4)));
typedef float f32x16 __attribute__((ext_vector_type(16)));
typedef unsigned u32x4 __attribute__((ext_vector_type(4)));
typedef unsigned u32x2 __attribute__((ext_vector_type(2)));
#define DI __device__ __forceinline__
#define LDS_WAIT() asm volatile("s_waitcnt lgkmcnt(0)" ::: "memory")

constexpr int D = 2048, DFF = 5632, NB = 4, LP = 2064, NS = 128, LS = 8;
constexpr int PROWS = NB * LP;
constexpr int NTOK = PROWS + NS * LS;
constexpr int MR = 9472;
constexpr int NIN = 8448;
constexpr int NCH = 33;
constexpr int NITEM = NB * NCH * 4;
constexpr float EPS = 1e-6f;

constexpr size_t AL(size_t x) { return (x + 255) & ~(size_t)255; }
constexpr size_t WS_SSQ = 0;
constexpr size_t WS_BAR = AL(WS_SSQ + 3 * MR * 4);
constexpr size_t WS_CNT = AL(WS_BAR + 16384);
constexpr size_t WS_ZIF = AL(WS_CNT + 4 * 256);
constexpr size_t WS_GB = AL(WS_ZIF + MR * 8 * 4);
constexpr size_t WS_GI = AL(WS_GB + MR * 4 * 4);
constexpr size_t WS_ITS = AL(WS_GI + MR * 4 * 4);
constexpr size_t WS_DN = AL(WS_ITS + 3 * NITEM * 4);
constexpr size_t WS_NJ = AL(WS_DN + NITEM * 128 * 4);
constexpr size_t WS_A8 = AL(WS_NJ + NITEM * 128 * 4);
constexpr size_t WS_S5M = AL(WS_A8 + 64 * 64 * 2 * 4);
constexpr size_t WFF_BYTES = (size_t)2 * DFF * D * 2 + (size_t)D * DFF * 2;
constexpr size_t WS_WFF = AL(WS_S5M + (size_t)64 * 3 * 16384 * 2);
constexpr size_t WS_WIN = AL(WS_WFF + WFF_BYTES);
constexpr size_t WS_WGLU = AL(WS_WIN + (size_t)NIN * D * 2);
constexpr size_t WS_WBS = AL(WS_WGLU + (size_t)1024 * 1024 * 2);
constexpr size_t WS_WBM = AL(WS_WBS + (size_t)2048 * 1024 * 2);
constexpr size_t WS_WOUT = AL(WS_WBM + (size_t)2048 * 1024 * 2);
constexpr size_t WS_XA = AL(WS_WOUT + (size_t)2048 * 2048 * 2);
constexpr size_t WS_HID = AL(WS_XA + (size_t)MR * D * 2);
constexpr size_t WS_H = AL(WS_HID + (size_t)MR * DFF * 2);
constexpr size_t WS_US5 = AL(WS_H + (size_t)MR * D * 4);
constexpr size_t WS_QKPRE = AL(WS_US5 + (size_t)MR * 1024 * 4);
constexpr size_t WS_SIGO = AL(WS_QKPRE + (size_t)MR * 1024 * 4);
constexpr size_t WS_QK = AL(WS_SIGO + (size_t)MR * 1024 * 2);
constexpr size_t WS_YS5P = AL(WS_QK + (size_t)MR * 1024 * 2);
constexpr size_t WS_END = AL(WS_YS5P + (size_t)MR * 1024 * 2);
static_assert((size_t)NITEM * 32768 * 4 <= WFF_BYTES, "DC overlay");
static_assert((size_t)NITEM * 32768 * 2 <= (size_t)MR * D * 2, "CJ overlay");

constexpr size_t O_YP = 0, O_YS = O_YP + (size_t)NB * 2048 * 2048, O_PS5R = O_YS + (size_t)NS * LS * 2048, O_PS5I = O_PS5R + NB * 4096,
                 O_PC = O_PS5I + NB * 4096, O_PN = O_PC + (size_t)NB * 4 * 32768, O_PM = O_PN + NB * 4 * 128, O_PCONV = O_PM + NB * 4,
                 O_SS5R = O_PCONV + NB * 3 * 1024, O_SS5I = O_SS5R + (size_t)NS * 4096, O_SC = O_SS5I + (size_t)NS * 4096,
                 O_SN = O_SC + (size_t)NS * 4 * 32768, O_SM = O_SN + NS * 4 * 128, O_SCONV = O_SM + NS * 4, O_END = O_SCONV + NS * 3 * 1024;

constexpr int LDS_BYTES = 288 * 512 + 1024;

DI unsigned pk2(float lo, float hi) {
    typedef __bf16 bf2 __attribute__((ext_vector_type(2)));
    f32x2 v = {lo, hi}; bf2 b = __builtin_convertvector(v, bf2); return __builtin_bit_cast(unsigned, b);
}
DI bf16x8 cvt_frag(f32x4 a, f32x4 b) { u32x4 w; w.x = pk2(a.x, a.y); w.y = pk2(a.z, a.w); w.z = pk2(b.x, b.y); w.w = pk2(b.z, b.w); return __builtin_bit_cast(bf16x8, w); }
DI float bflo(unsigned w) { return __uint_as_float(w << 16); }
DI float bfhi(unsigned w) { return __uint_as_float(w & 0xffff0000u); }
DI float bf1(bf16_t v) { return __uint_as_float(((unsigned)v) << 16); }
DI bf16_t f2bf(float f) { return (bf16_t)(pk2(f, 0.f) & 0xffffu); }
DI float sigmoidf_(float x) { return __builtin_amdgcn_rcpf(1.0f + __expf(-x)); }
DI float siluf_(float x) { return x * sigmoidf_(x); }
DI float gelu_tanh(float x) { const float u = 0.7978845608028654f * (x + 0.044715f * x * x * x); return x * sigmoidf_(2.0f * u); }
DI int crow(int reg, int h) { return (reg & 3) + 8 * (reg >> 2) + 4 * h; }
#define MFMA32(a, b, c) __builtin_amdgcn_mfma_f32_32x32x16_bf16((a), (b), (c), 0, 0, 0)
DI f32x16 zero16() { f32x16 z; for (int i = 0; i < 16; ++i) z[i] = 0.f; return z; }
DI float wave_max(float v) { for (int o = 1; o < 64; o <<= 1) v = fmaxf(v, __shfl_xor(v, o)); return v; }
DI float wave_sum(float v) { for (int o = 1; o < 64; o <<= 1) v += __shfl_xor(v, o); return v; }

namespace pg8 {
constexpr int BM = 256, BK = 64, HALF = 128, HTB = HALF * BK * 2, STAGE_BYTES = 8 * HTB, NXCD = 8, WGM = 8;
DI int lds_byte(int r, int c) { const int st = (r >> 4) * 2 + (c >> 5), rr = r & 15, cc = c & 31, ob = rr * 64 + cc * 2; return st * 1024 + (ob ^ (((ob >> 9) & 1) << 5)); }
DI void stage_rc(int b, int& R, int& C) { const int st = b / 1024, sb = b % 1024, swz = sb ^ (((sb >> 9) & 1) << 5); R = (st >> 1) * 16 + swz / 64; C = (st & 1) * 32 + (swz % 64) / 2; }
DI int perm32(int rho) { const int n = rho >> 4, i = rho & 15; return 8 * (i >> 2) + 4 * n + (i & 3); }
struct Unit { int pm, pn, sub, mask; };
struct Gemm { const bf16_t* A0; const bf16_t* A1; const bf16_t* B0; const bf16_t* B1; int K; };
struct Order {
    int nM, nN, nwg, G, c, nsub, full, R, parts;
    DI void init(int M, int N, int G_, int c_, int nsub_, int maxparts) { nM = M / BM; nN = N / BM; nwg = nM * nN; G = G_; c = c_; nsub = nsub_;
        full = nwg / G; R = nwg - full * G; parts = (R > 0 && 4 * R <= G && maxparts >= 4) ? 4 : ((R > 0 && 2 * R <= G && maxparts >= 2) ? 2 : 1); }
    DI void tile(int wgid, Unit& u) const {
        { const int q = nwg / NXCD, r = nwg % NXCD, xcd = wgid % NXCD, off = wgid / NXCD; wgid = (xcd < r ? xcd * (q + 1) : r * (q + 1) + (xcd - r) * q) + off; }
        const int nig = WGM * nN, gid = wgid / nig, fm = gid * WGM, gsz = (nM - fm) < WGM ? (nM - fm) : WGM;
        u.pm = fm + ((wgid % nig) % gsz); u.pn = (wgid % nig) / gsz; }
    DI bool next(int i, Unit& u) const {
        const int ti = i / nsub; u.sub = i - ti * nsub; u.mask = 15;
        if (ti < full || parts < 2) { const long L = (long)ti * G + c; if (L >= nwg) return false; tile((int)L, u); return true; }
        if (ti > full || c >= R * parts) return false;
        const int j = c / parts, part = c - j * parts; tile(full * G + j, u);
        u.mask = parts == 4 ? (1 << part) : (part ? 12 : 3); return true;
    }
};
template <class Epi>
DI void gemm_phase(LAS unsigned char* lds, const Gemm g, const Order S, const Epi E) {
    const int tid = threadIdx.x, wid = __builtin_amdgcn_readfirstlane(tid >> 6), lane = tid & 63, wr = wid >> 2, wc = wid & 3, fr = lane & 15, fq = lane >> 4;
    const int K = g.K, nt = K / BK;
    unsigned voffA[2], voffB[2];
#pragma unroll
    for (int i = 0; i < 2; ++i) { int R, C; stage_rc(tid * 16 + i * 8192, R, C); const int Rb = (R & ~31) + perm32(R & 31);
        voffA[i] = (unsigned)(R * K + C) * 2u; voffB[i] = (unsigned)(Rb * K + C) * 2u; }
    const size_t kstep = (size_t)(BK * 2);
    const size_t hstep = (size_t)HALF * K * 2;
    const size_t tstep = 2 * hstep;
    const unsigned ldsw = (unsigned)wid * 1024u;
    const int aoff = lds_byte(wr * 64 + fr, fq * 8), boff = lds_byte(wc * 32 + fr, fq * 8);
#define PG8_SA(b, h) (((b) * 2 + (h)) * HTB)
#define PG8_SB(b, h) ((4 + (b) * 2 + (h)) * HTB)
#define PG8_STAGE(bufoff, gbase, voff) do { _Pragma("unroll") for (int _i = 0; _i < 2; ++_i) \
        __builtin_amdgcn_global_load_lds((const unsigned*)((const char*)(gbase) + (voff)[_i]), (LAS unsigned*)(lds + (bufoff) + ldsw + _i * 8192), 16, 0, 0); } while (0)
#define PG8_STAGEM(need, bufoff, gbase, voff) do { const bool _n = (need); const char* _b = _n ? (const char*)(gbase) : (const char*)g.A0; _Pragma("unroll") for (int _i = 0; _i < 2; ++_i) \
        __builtin_amdgcn_global_load_lds((const unsigned*)(_b + (_n ? (voff)[_i] : 0u)), (LAS unsigned*)(lds + (bufoff) + ldsw + _i * 8192), 16, 0, 0); } while (0)
#define PG8_LDA(dst, b, h) do { _Pragma("unroll") for (int m = 0; m < 4; ++m) _Pragma("unroll") for (int k = 0; k < 2; ++k) dst[m][k] = *(const LAS bf16x8*)(lds + PG8_SA(b, h) + aoff + m * 2048 + k * 1024); } while (0)
#define PG8_LDB(dst, b, h) do { _Pragma("unroll") for (int n = 0; n < 2; ++n) _Pragma("unroll") for (int k = 0; k < 2; ++k) dst[n][k] = *(const LAS bf16x8*)(lds + PG8_SB(b, h) + boff + n * 2048 + k * 1024); } while (0)
#define PG8_MMA(ai, bj, At, Bt) do { __builtin_amdgcn_s_setprio(1); _Pragma("unroll") for (int m = 0; m < 4; ++m) _Pragma("unroll") for (int n = 0; n < 2; ++n) _Pragma("unroll") for (int k = 0; k < 2; ++k) \
        acc[ai][bj][m][n] = __builtin_amdgcn_mfma_f32_16x16x32_bf16(Bt[n][k], At[m][k], acc[ai][bj][m][n], 0, 0, 0); __builtin_amdgcn_s_setprio(0); } while (0)
#define PG8_WAIT_V(n) asm volatile("s_waitcnt vmcnt(" #n ")" ::: "memory")
#define PG8_WAIT_L(n) asm volatile("s_waitcnt lgkmcnt(" #n ")" ::: "memory")
#define PG8_BAR __builtin_amdgcn_s_barrier()
#define PG8_SCHED __builtin_amdgcn_sched_barrier(0)
    Unit cur, nxt; int ui = 0;
    if (!S.next(0, cur)) return;
    f32x4 acc[2][2][4][2];
#pragma unroll
    for (int a = 0; a < 2; ++a)
#pragma unroll
        for (int b = 0; b < 2; ++b)
#pragma unroll
            for (int m = 0; m < 4; ++m)
#pragma unroll
                for (int n = 0; n < 2; ++n) acc[a][b][m][n] = (f32x4){0.f, 0.f, 0.f, 0.f};
    bf16x8 At[4][2], B0[2][2], B1[2][2];
    const char* cA = (const char*)(cur.sub ? g.A1 : g.A0) + (size_t)cur.pm * tstep; const char* cB = (const char*)(cur.sub ? g.B1 : g.B0) + (size_t)cur.pn * tstep;
    PG8_STAGE(PG8_SB(0, 0), cB, voffB); PG8_STAGE(PG8_SB(0, 1), cB + hstep, voffB); PG8_STAGE(PG8_SA(0, 0), cA, voffA); PG8_STAGE(PG8_SA(0, 1), cA + hstep, voffA);
    if (wr == 1) PG8_BAR;
    PG8_WAIT_V(2); PG8_BAR;
    PG8_STAGE(PG8_SB(1, 0), cB + kstep, voffB); PG8_STAGE(PG8_SA(1, 0), cA + kstep, voffA); PG8_STAGE(PG8_SB(1, 1), cB + hstep + kstep, voffB);
    PG8_WAIT_V(6); PG8_BAR;
    for (;;) {
        const bool has_next = S.next(ui + 1, nxt);
        const char* nA = has_next ? (const char*)(nxt.sub ? g.A1 : g.A0) + (size_t)nxt.pm * tstep : cA; const char* nB = has_next ? (const char*)(nxt.sub ? g.B1 : g.B0) + (size_t)nxt.pn * tstep : cB;
        const int mk = cur.mask;
        for (int t = 0; t < nt; t += 2) {
            const bool last = (t == nt - 2);
            const char* a1 = cA + (size_t)(t + 1) * kstep;
            const char* a2 = last ? nA : cA + (size_t)(t + 2) * kstep; const char* b2 = last ? nB : cB + (size_t)(t + 2) * kstep;
            const char* a3 = a2 + kstep; const char* b3 = b2 + kstep;
            const int mn = (last && has_next) ? nxt.mask : mk;
            PG8_LDB(B0, 0, 0); PG8_LDB(B1, 0, 1); PG8_SCHED; PG8_LDA(At, 0, 0); PG8_STAGEM(mk & 12, PG8_SA(1, 1), a1 + hstep, voffA);
            PG8_WAIT_V(8); PG8_WAIT_L(0); PG8_BAR; if (mk & 1) PG8_MMA(0, 0, At, B0); if (mk & 2) PG8_MMA(0, 1, At, B1); PG8_BAR; PG8_SCHED;
            PG8_LDA(At, 0, 1); PG8_STAGEM(mn & 5, PG8_SB(0, 0), b2, voffB); PG8_STAGEM(mn & 10, PG8_SB(0, 1), b2 + hstep, voffB); PG8_STAGEM(mn & 3, PG8_SA(0, 0), a2, voffA);
            PG8_WAIT_V(8); PG8_WAIT_L(0); PG8_BAR; if (mk & 4) PG8_MMA(1, 0, At, B0); if (mk & 8) PG8_MMA(1, 1, At, B1); PG8_BAR; PG8_SCHED;
            PG8_LDB(B0, 1, 0); PG8_LDB(B1, 1, 1); PG8_SCHED; PG8_LDA(At, 1, 0); PG8_STAGEM(mn & 12, PG8_SA(0, 1), a2 + hstep, voffA);
            PG8_WAIT_V(8); PG8_WAIT_L(0); PG8_BAR; if (mk & 1) PG8_MMA(0, 0, At, B0); if (mk & 2) PG8_MMA(0, 1, At, B1); PG8_BAR; PG8_SCHED;
            PG8_LDA(At, 1, 1); PG8_STAGEM(mn & 5, PG8_SB(1, 0), b3, voffB); PG8_STAGEM(mn & 10, PG8_SB(1, 1), b3 + hstep, voffB); PG8_STAGEM(mn & 3, PG8_SA(1, 0), a3, voffA);
            PG8_WAIT_V(8); PG8_WAIT_L(0); PG8_BAR; if (mk & 4) PG8_MMA(1, 0, At, B0); if (mk & 8) PG8_MMA(1, 1, At, B1); PG8_BAR; PG8_SCHED;
        }
        if (wr == 0) PG8_BAR;
        E(acc, cur, wr, wc, fr, fq);
        if (!has_next) break;
#pragma unroll
        for (int a = 0; a < 2; ++a)
#pragma unroll
            for (int b = 0; b < 2; ++b)
#pragma unroll
                for (int m = 0; m < 4; ++m)
#pragma unroll
                    for (int n = 0; n < 2; ++n) acc[a][b][m][n] = (f32x4){0.f, 0.f, 0.f, 0.f};
        cur = nxt; cA = nA; cB = nB; ++ui;
        if (wr == 1) PG8_BAR;
    }
    PG8_WAIT_V(0);
    PG8_BAR;
#undef PG8_SA
#undef PG8_SB
#undef PG8_STAGE
#undef PG8_STAGEM
#undef PG8_LDA
#undef PG8_LDB
#undef PG8_MMA
#undef PG8_WAIT_V
#undef PG8_WAIT_L
#undef PG8_BAR
#undef PG8_SCHED
}
}
typedef f32x4 AccT[2][2][4][2];

struct Params {
    const float* in[37];
    float* out; unsigned char* ws;
    int ph_lo, ph_hi;
};
enum { I_XP = 0, I_XS, I_S5RE, I_S5IM, I_MC, I_MN, I_MM, I_MCONV, I_META, I_F1N, I_F1G, I_F1U, I_F1D, I_MIXN, I_WIN, I_AR, I_AI, I_LDT, I_BR, I_BI, I_CR, I_CI, I_S5D, I_WGLU,
       I_CW, I_CB, I_MBI, I_MBF, I_MNORM, I_WBS, I_WBM, I_WOUT, I_F2N, I_F2G, I_F2U, I_F2D, I_FINN };

struct Frame {
    LAS unsigned char* lds;
    const Params* P;
    unsigned char* ws;
    int tid, lane, wave, G, bid;
};
DI const float* xrow(const Params& P, int r) {
    if (r < PROWS) { const int b = r / LP, t = r - b * LP; return t < 16 ? P.in[I_META] + (size_t)t * D : P.in[I_XP] + ((size_t)b * 2048 + (t - 16)) * D; }
    if (r < NTOK) return P.in[I_XS] + (size_t)(r - PROWS) * D;
    return nullptr;
}

struct EpiSwiglu {
    bf16_t* HID; const float* ssq;
    DI void operator()(const AccT& acc, const pg8::Unit& u, int wr, int wc, int fr, int fq) const {
        const int row0 = u.pm * 256 + wr * 64 + fr, col0 = u.pn * 128 + wc * 32 + 8 * fq;
        float rsv[8];
#pragma unroll
        for (int q = 0; q < 8; ++q) rsv[q] = ssq ? ssq[row0 + (q >> 2) * 128 + (q & 3) * 16] : 0.f;
#pragma unroll
        for (int ai = 0; ai < 2; ++ai)
#pragma unroll
            for (int m = 0; m < 4; ++m) {
                if (!((u.mask >> (ai * 2)) & 1)) continue;
                const int r = row0 + ai * 128 + m * 16;
                const float rs = ssq ? rsqrtf(rsv[ai * 4 + m] * (1.0f / D) + EPS) : 1.0f;
                float h[8];
#pragma unroll
                for (int n = 0; n < 2; ++n)
#pragma unroll
                    for (int j = 0; j < 4; ++j) h[n * 4 + j] = siluf_(acc[ai][0][m][n][j] * rs) * (acc[ai][1][m][n][j] * rs);
                u32x4 w; w.x = pk2(h[0], h[1]); w.y = pk2(h[2], h[3]); w.z = pk2(h[4], h[5]); w.w = pk2(h[6], h[7]);
                *(u32x4*)(HID + (size_t)r * DFF + col0) = w;
            }
    }
};
template <int MODE> struct EpiResid {
    const Params* P;
    DI void operator()(const AccT& acc, const pg8::Unit& u, int wr, int wc, int fr, int fq) const {
        const bool from_inputs = MODE == 0; const float scale = MODE == 1 ? 1.0f : 0.5f;
        float* const H = (float*)(P->ws + WS_H); float* const ssq = (float*)(P->ws + WS_SSQ) + MODE * MR;
        const float* const gain = MODE == 0 ? P->in[I_MIXN] : (MODE == 1 ? P->in[I_F2N] : nullptr); bf16_t* const Aout = MODE < 2 ? (bf16_t*)(P->ws + WS_XA) : nullptr;
        const int row0 = u.pm * 256 + wr * 64 + fr, col0 = u.pn * 256 + wc * 32 + 8 * fq;
        f32x4 gv[2][2];
#pragma unroll
        for (int bj = 0; bj < 2; ++bj) { gv[bj][0] = (f32x4){1.f, 1.f, 1.f, 1.f}; gv[bj][1] = gv[bj][0]; if (MODE < 2) { gv[bj][0] = *(const f32x4*)(gain + col0 + bj * 128); gv[bj][1] = *(const f32x4*)(gain + col0 + bj * 128 + 4); } }
#pragma unroll
        for (int ai = 0; ai < 2; ++ai) {
            if ((u.mask >> (ai * 2)) & 3) {
            f32x4 rv[4][2][2];
#pragma unroll
            for (int m = 0; m < 4; ++m) { const int r = row0 + ai * 128 + m * 16; const float* res = from_inputs ? xrow(*P, r) : H + (size_t)r * D;
#pragma unroll
                for (int bj = 0; bj < 2; ++bj) { rv[m][bj][0] = (f32x4){0.f, 0.f, 0.f, 0.f}; rv[m][bj][1] = rv[m][bj][0];
                    if (res && ((u.mask >> (ai * 2 + bj)) & 1)) { rv[m][bj][0] = *(const f32x4*)(res + col0 + bj * 128); rv[m][bj][1] = *(const f32x4*)(res + col0 + bj * 128 + 4); } } }
#pragma unroll
            for (int m = 0; m < 4; ++m) {
                const int r = row0 + ai * 128 + m * 16;
                float ss = 0.f;
#pragma unroll
                for (int bj = 0; bj < 2; ++bj) {
                    if ((u.mask >> (ai * 2 + bj)) & 1) {
                    const int c = col0 + bj * 128;
                    const f32x4 v0 = rv[m][bj][0] + acc[ai][bj][m][0] * scale, v1 = rv[m][bj][1] + acc[ai][bj][m][1] * scale;
                    *(f32x4*)(H + (size_t)r * D + c) = v0; *(f32x4*)(H + (size_t)r * D + c + 4) = v1;
                    ss += (v0.x * v0.x + v0.y * v0.y) + (v0.z * v0.z + v0.w * v0.w) + (v1.x * v1.x + v1.y * v1.y) + (v1.z * v1.z + v1.w * v1.w);
                    if (MODE < 2) { const f32x4 g0 = gv[bj][0], g1 = gv[bj][1];
                        u32x4 w; w.x = pk2(v0.x * g0.x, v0.y * g0.y); w.y = pk2(v0.z * g0.z, v0.w * g0.w); w.z = pk2(v1.x * g1.x, v1.y * g1.y); w.w = pk2(v1.z * g1.z, v1.w * g1.w);
                        *(u32x4*)(Aout + (size_t)r * D + c) = w; }
                    }
                }
                ss += __shfl_xor(ss, 16); ss += __shfl_xor(ss, 32);
                if (fq == 0) atomicAdd(ssq + r, ss);
            } }
        }
    }
};
struct EpiWin {
    float* US5; float* QKPRE; bf16_t* V; bf16_t* SIGO; bf16_t* GATES; float* ZIF; const float* ssq;
    DI void operator()(const AccT& acc, const pg8::Unit& u, int wr, int wc, int fr, int fq) const {
        const int row0 = u.pm * 256 + wr * 64 + fr, pn = u.pn, cl = wc * 32 + 8 * fq;
        float rsv[8];
#pragma unroll
        for (int q = 0; q < 8; ++q) rsv[q] = ssq[row0 + (q >> 2) * 128 + (q & 3) * 16];
#pragma unroll
        for (int ai = 0; ai < 2; ++ai)
#pragma unroll
            for (int m = 0; m < 4; ++m) {
                const int r = row0 + ai * 128 + m * 16;
                const float rs = rsqrtf(rsv[ai * 4 + m] * (1.0f / D) + EPS);
#pragma unroll
                for (int bj = 0; bj < 2; ++bj) {
                    const int c = pn * 256 + bj * 128 + cl;
                    f32x4 v0 = acc[ai][bj][m][0] * rs, v1 = acc[ai][bj][m][1] * rs;
                    if (pn < 8) { float* dst = (pn < 4 ? US5 + (size_t)r * 1024 + c : QKPRE + (size_t)r * 1024 + (c - 1024)); *(f32x4*)dst = v0; *(f32x4*)(dst + 4) = v1; }
                    else if (pn < 32) {
                        if (pn >= 12) {
#pragma unroll
                            for (int j = 0; j < 4; ++j) { v0[j] = sigmoidf_(v0[j]); v1[j] = sigmoidf_(v1[j]); } }
                        u32x4 w; w.x = pk2(v0.x, v0.y); w.y = pk2(v0.z, v0.w); w.z = pk2(v1.x, v1.y); w.w = pk2(v1.z, v1.w);
                        bf16_t* dst = pn < 12 ? V + (size_t)r * 1024 + (c - 2048) : (pn < 16 ? SIGO + (size_t)r * 1024 + (c - 3072) : GATES + (size_t)r * 4096 + (c - 4096));
                        *(u32x4*)dst = w; }
                    else if (bj == 0 && cl == 0) { *(f32x4*)(ZIF + (size_t)r * 8) = v0; *(f32x4*)(ZIF + (size_t)r * 8 + 4) = v1; }
                }
            }
    }
};
struct EpiGlu {
    const bf16_t* YP; bf16_t* YO;
    DI void operator()(const AccT& acc, const pg8::Unit& u, int wr, int wc, int fr, int fq) const {
        const int row0 = u.pm * 256 + wr * 64 + fr, col0 = u.pn * 256 + wc * 32 + 8 * fq;
        u32x4 yv[8][2];
#pragma unroll
        for (int q = 0; q < 8; ++q)
#pragma unroll
            for (int bj = 0; bj < 2; ++bj) yv[q][bj] = *(const u32x4*)(YP + (size_t)(row0 + (q >> 2) * 128 + (q & 3) * 16) * 1024 + col0 + bj * 128);
#pragma unroll
        for (int ai = 0; ai < 2; ++ai)
#pragma unroll
            for (int m = 0; m < 4; ++m) {
                const int r = row0 + ai * 128 + m * 16;
#pragma unroll
                for (int bj = 0; bj < 2; ++bj) {
                    const size_t o = (size_t)r * 1024 + col0 + bj * 128;
                    const u32x4 y = yv[ai * 4 + m][bj]; const f32x4 a0 = acc[ai][bj][m][0], a1 = acc[ai][bj][m][1];
                    u32x4 w; w.x = pk2(bflo(y.x) * sigmoidf_(a0.x), bfhi(y.x) * sigmoidf_(a0.y)); w.y = pk2(bflo(y.y) * sigmoidf_(a0.z), bfhi(y.y) * sigmoidf_(a0.w));
                    w.z = pk2(bflo(y.z) * sigmoidf_(a1.x), bfhi(y.z) * sigmoidf_(a1.y)); w.w = pk2(bflo(y.w) * sigmoidf_(a1.z), bfhi(y.w) * sigmoidf_(a1.w));
                    *(u32x4*)(YO + o) = w; }
            }
    }
};
struct EpiBranch {
    const bf16_t* GATES; bf16_t* MG;
    DI void operator()(const AccT& acc, const pg8::Unit& u, int wr, int wc, int fr, int fq) const {
        const int row0 = u.pm * 256 + wr * 64 + fr, col0 = u.pn * 256 + wc * 32 + 8 * fq;
#pragma unroll
        for (int ai = 0; ai < 2; ++ai) {
            if ((u.mask >> (ai * 2)) & 3) {
            u32x4 gt[4][2], pv[4][2];
#pragma unroll
            for (int m = 0; m < 4; ++m)
#pragma unroll
                for (int bj = 0; bj < 2; ++bj) { const int r = row0 + ai * 128 + m * 16, c = col0 + bj * 128; gt[m][bj] = (u32x4){0u, 0u, 0u, 0u}; pv[m][bj] = gt[m][bj];
                    if ((u.mask >> (ai * 2 + bj)) & 1) { gt[m][bj] = *(const u32x4*)(GATES + (size_t)r * 4096 + u.sub * 2048 + c); if (u.sub) pv[m][bj] = *(const u32x4*)(MG + (size_t)r * D + c); } }
#pragma unroll
            for (int m = 0; m < 4; ++m) {
                const int r = row0 + ai * 128 + m * 16;
#pragma unroll
                for (int bj = 0; bj < 2; ++bj) {
                    if ((u.mask >> (ai * 2 + bj)) & 1) {
                    const int c = col0 + bj * 128;
                    const u32x4 g = gt[m][bj], p = pv[m][bj]; const f32x4 a0 = acc[ai][bj][m][0], a1 = acc[ai][bj][m][1];
                    float v[8] = {bflo(g.x) * a0.x, bfhi(g.x) * a0.y, bflo(g.y) * a0.z, bfhi(g.y) * a0.w, bflo(g.z) * a1.x, bfhi(g.z) * a1.y, bflo(g.w) * a1.z, bfhi(g.w) * a1.w};
                    if (u.sub) { v[0] += bflo(p.x); v[1] += bfhi(p.x); v[2] += bflo(p.y); v[3] += bfhi(p.y); v[4] += bflo(p.z); v[5] += bfhi(p.z); v[6] += bflo(p.w); v[7] += bfhi(p.w); }
                    u32x4 w; w.x = pk2(v[0], v[1]); w.y = pk2(v[2], v[3]); w.z = pk2(v[4], v[5]); w.w = pk2(v[6], v[7]);
                    *(u32x4*)(MG + (size_t)r * D + c) = w; } }
            } }
        }
    }
};

DI void tr_item(const float* W, int N, int srcn0, int nvalid, bf16_t* WT, int K, int dstrow0, int k0, LAS float* scr, int lane) {
    const int c4 = lane & 7, k8 = lane >> 3;
#pragma unroll
    for (int i = 0; i < 8; ++i) { const int kk = 8 * i + k8; f32x4 v = (f32x4){0.f, 0.f, 0.f, 0.f};
        if (4 * c4 < nvalid) v = __builtin_nontemporal_load((const f32x4*)(W + (size_t)(k0 + kk) * N + srcn0 + 4 * c4));
        LAS float* d = scr + kk * 33 + 4 * c4; d[0] = v.x; d[1] = v.y; d[2] = v.z; d[3] = v.w; }
    LDS_WAIT();
    const int c = lane & 7;
#pragma unroll
    for (int j = 0; j < 4; ++j) { const int n = (lane >> 3) + 8 * j; const LAS float* s = scr + (8 * c) * 33 + n;
        u32x4 o; o.x = pk2(s[0 * 33], s[1 * 33]); o.y = pk2(s[2 * 33], s[3 * 33]); o.z = pk2(s[4 * 33], s[5 * 33]); o.w = pk2(s[6 * 33], s[7 * 33]);
        *(u32x4*)(WT + (size_t)(dstrow0 + n) * K + k0 + 8 * c) = o; }
    LDS_WAIT();
}
constexpr int FFN_ITEMS_GU = 32 * 352, FFN_ITEMS_D = 88 * 64, FFN_ITEMS = FFN_ITEMS_GU + FFN_ITEMS_D;
DI void ffn_conv_item(const float* wg, const float* wu, const float* wd, bf16_t* dst, int it, LAS float* scr, int lane) {
    if (it < FFN_ITEMS_GU) { const int kb = it / 352, nb = it - kb * 352, d0 = nb * 32, tile = d0 >> 8, w = d0 & 255;
        tr_item(w < 128 ? wg : wu, DFF, tile * 128 + (w & 127), 32, dst, D, d0, kb * 64, scr, lane); }
    else { it -= FFN_ITEMS_GU; const int kb = it / 64, nb = it - kb * 64;
        tr_item(wd, D, nb * 32, 32, dst + (size_t)2 * DFF * D, DFF, nb * 32, kb * 64, scr, lane); }
}
DI void rms_row(Frame& F, int r, const float* gain, bf16_t* out) {
    const float* x = xrow(*F.P, r); u32x2* o = (u32x2*)(out + (size_t)r * D);
    if (!x) { for (int j = 0; j < 8; ++j) o[64 * j + F.lane] = (u32x2){0u, 0u}; return; }
    f32x4 v[8]; float s = 0.f;
#pragma unroll
    for (int j = 0; j < 8; ++j) { v[j] = ((const f32x4*)x)[64 * j + F.lane]; s += (v[j].x * v[j].x + v[j].y * v[j].y) + (v[j].z * v[j].z + v[j].w * v[j].w); }
    const float rs = rsqrtf(wave_sum(s) * (1.0f / D) + EPS);
#pragma unroll
    for (int j = 0; j < 8; ++j) { const f32x4 g = ((const f32x4*)gain)[64 * j + F.lane];
        o[64 * j + F.lane] = (u32x2){pk2(v[j].x * rs * g.x, v[j].y * rs * g.y), pk2(v[j].z * rs * g.z, v[j].w * rs * g.w)}; }
}
DI void s5_precompute(Frame& F, int g) {
    const Params& P = *F.P;
    LAS float* pw = (LAS float*)F.lds;
    LAS float* Bb = pw + 9 * 128;
    LAS float* Cc = Bb + 2048;
    LAS float* Kd = Cc + 2048;
    const int tid = F.tid;
    if (tid < 64) { const int p = tid;
        const float are = P.in[I_AR][g * 64 + p], aim = P.in[I_AI][g * 64 + p], dt = expf(P.in[I_LDT][g]);
        const float er = expf(are * dt), ang = aim * dt; const float ar = er * cosf(ang), ai = er * sinf(ang);
        float pr = 1.f, pi = 0.f;
        for (int d = 0; d <= 8; ++d) { pw[(d * 64 + p) * 2] = pr; pw[(d * 64 + p) * 2 + 1] = pi; const float nr = pr * ar - pi * ai, ni = pr * ai + pi * ar; pr = nr; pi = ni; }
        float* a8 = (float*)(F.ws + WS_A8) + (g * 64 + p) * 2; a8[0] = pw[(8 * 64 + p) * 2]; a8[1] = pw[(8 * 64 + p) * 2 + 1];
        const float nr = ar - 1.f, ni = ai, den = 1.0f / (are * are + aim * aim);
        const float cr = (nr * are + ni * aim) * den, ci = (ni * are - nr * aim) * den;
        for (int h = 0; h < 16; ++h) { const float br = P.in[I_BR][(g * 64 + p) * 16 + h], bi = P.in[I_BI][(g * 64 + p) * 16 + h];
            Bb[(p * 16 + h) * 2] = cr * br - ci * bi; Bb[(p * 16 + h) * 2 + 1] = cr * bi + ci * br; }
    }
    for (int e = tid; e < 1024; e += 512) { Cc[e * 2] = P.in[I_CR][g * 1024 + e]; Cc[e * 2 + 1] = P.in[I_CI][g * 1024 + e]; }
    __syncthreads();
    bf16_t* Em = (bf16_t*)(F.ws + WS_S5M) + (size_t)g * 3 * 16384; bf16_t* Mm = Em + 16384; bf16_t* Fm = Em + 32768;
    for (int e = tid; e < 2048; e += 512) { const int d = e >> 8, h = (e >> 4) & 15, h2 = e & 15; float s = 0.f;
        for (int p = 0; p < 64; ++p) { const float cr = Cc[(h * 64 + p) * 2], ci = Cc[(h * 64 + p) * 2 + 1], wr_ = pw[(d * 64 + p) * 2], wi = pw[(d * 64 + p) * 2 + 1];
            const float xr = cr * wr_ - ci * wi, xi = cr * wi + ci * wr_; s += xr * Bb[(p * 16 + h2) * 2] - xi * Bb[(p * 16 + h2) * 2 + 1]; }
        Kd[e] = s; }
    for (int e = tid; e < 16384; e += 512) { const int n = e >> 7, k = e & 127;
        { const int ri = n >> 6, p = n & 63, s = k >> 4, h2 = k & 15; const float wr_ = pw[((7 - s) * 64 + p) * 2], wi = pw[((7 - s) * 64 + p) * 2 + 1], br = Bb[(p * 16 + h2) * 2], bi = Bb[(p * 16 + h2) * 2 + 1];
          Em[e] = f2bf(ri ? wr_ * bi + wi * br : wr_ * br - wi * bi); }
        { const int t = n >> 4, h = n & 15, ri = k >> 6, p = k & 63; const float cr = Cc[(h * 64 + p) * 2], ci = Cc[(h * 64 + p) * 2 + 1], wr_ = pw[((t + 1) * 64 + p) * 2], wi = pw[((t + 1) * 64 + p) * 2 + 1];
          Fm[e] = f2bf(ri ? -(cr * wi + ci * wr_) : cr * wr_ - ci * wi); }
    }
    __syncthreads();
    for (int e = tid; e < 16384; e += 512) { const int n = e >> 7, k = e & 127, t = n >> 4, h = n & 15, s = k >> 4, h2 = k & 15;
        Mm[e] = f2bf(s <= t ? Kd[((t - s) * 16 + h) * 16 + h2] : 0.f); }
    __syncthreads();
}

DI int hsw(int r, int c) { return r * 128 + (c ^ ((r & 15) << 3)); }
constexpr int S5_UROW = 136;
DI void s5_item(Frame& F, int item) {
    const Params& P = *F.P;
    const bool samp = item >= 256; const int g = samp ? item - 256 : (item & 63), n = samp ? 0 : (item >> 6);
    const int npass = samp ? 1 : 2, prow = samp ? 128 : 129, nunits = samp ? 16 : 20, tokbase = samp ? PROWS : n * LP;
    LAS float* H = (LAS float*)F.lds;
    LAS bf16_t* U = (LAS bf16_t*)(F.lds + 160 * 512);
    const bf16_t* Em = (const bf16_t*)(F.ws + WS_S5M) + (size_t)g * 3 * 16384; const bf16_t* Mm = Em + 16384; const bf16_t* Fm = Em + 32768;
    const float* US5 = (const float*)(F.ws + WS_US5); bf16_t* YP = (bf16_t*)(F.ws + WS_YS5P);
    const int lane = F.lane, r31 = lane & 31, hh = lane >> 5;
    const float* a8p = (const float*)(F.ws + WS_A8) + (g * 64 + lane) * 2; const float ar = a8p[0], ai = a8p[1];
    float hr = 0.f, hi = 0.f;
#pragma unroll 1
    for (int pass = 0; pass < npass; ++pass) {
        const int tok0 = tokbase + pass * prow * 8;
        for (int e = F.tid; e < prow * 8 * 4; e += 512) { const int tk = e >> 2, q = e & 3; const f32x4 v = *(const f32x4*)(US5 + (size_t)(tok0 + tk) * 1024 + g * 16 + q * 4);
            *(LAS u32x2*)(U + (tk >> 3) * S5_UROW + (tk & 7) * 16 + q * 4) = (u32x2){pk2(v.x, v.y), pk2(v.z, v.w)}; }
        __syncthreads();
#pragma unroll 1
        for (int u = F.wave; u < nunits; u += 8) {
            const int rb = u >> 2, nb = u & 3, row = rb * 32 + r31; const bool valid = row < prow;
            bf16x8 bfr[8];
#pragma unroll
            for (int kb = 0; kb < 8; ++kb) bfr[kb] = *(const bf16x8*)(Em + (nb * 32 + r31) * 128 + kb * 16 + 8 * hh);
            f32x16 acc = zero16();
#pragma unroll
            for (int kb = 0; kb < 8; ++kb) { bf16x8 a = (bf16x8){0, 0, 0, 0, 0, 0, 0, 0}; if (valid) a = *(const LAS bf16x8*)(U + row * S5_UROW + kb * 16 + 8 * hh); acc = MFMA32(a, bfr[kb], acc); }
#pragma unroll
            for (int reg = 0; reg < 16; ++reg) H[hsw(rb * 32 + crow(reg, hh), nb * 32 + r31)] = acc[reg];
        }
        __syncthreads();
        if (samp) { for (int r = F.wave; r < 128; r += 8) { const size_t si = ((size_t)r * 64 + g) * 64 + lane; const float h0r = P.in[I_S5RE][si], h0i = P.in[I_S5IM][si];
                const float lr = H[hsw(r, lane)], li = H[hsw(r, 64 + lane)];
                P.out[O_SS5R + si] = ar * h0r - ai * h0i + lr; P.out[O_SS5I + si] = ar * h0i + ai * h0r + li; H[hsw(r, lane)] = h0r; H[hsw(r, 64 + lane)] = h0i; } }
        else if (F.wave == 0) {
#pragma unroll 1
            for (int j0 = 0; j0 < 136; j0 += 8) { float lr[8], li[8];
#pragma unroll
                for (int q = 0; q < 8; ++q) { const int j = j0 + q < 129 ? j0 + q : 128; lr[q] = H[hsw(j, lane)]; li[q] = H[hsw(j, 64 + lane)]; }
#pragma unroll
                for (int q = 0; q < 8; ++q) { if (j0 + q < 129) { H[hsw(j0 + q, lane)] = hr; H[hsw(j0 + q, 64 + lane)] = hi;
                    const float nr = ar * hr - ai * hi + lr[q], ni = ar * hi + ai * hr + li[q]; hr = nr; hi = ni; } } }
            if (pass == 1) { const size_t si = ((size_t)n * 64 + g) * 64 + lane; P.out[O_PS5R + si] = hr; P.out[O_PS5I + si] = hi; } }
        __syncthreads();
#pragma unroll 1
        for (int u = F.wave; u < nunits; u += 8) {
            const int rb = u >> 2, nb = u & 3, row = rb * 32 + r31; const bool valid = row < prow;
            const int col = nb * 32 + r31, t = col >> 4, ch = g * 16 + (col & 15); const float Dv = P.in[I_S5D][ch];
            bf16x8 mfr[8], ffr[8]; float uo[16];
#pragma unroll
            for (int kb = 0; kb < 8; ++kb) { mfr[kb] = *(const bf16x8*)(Mm + (nb * 32 + r31) * 128 + kb * 16 + 8 * hh); ffr[kb] = *(const bf16x8*)(Fm + (nb * 32 + r31) * 128 + kb * 16 + 8 * hh); }
#pragma unroll
            for (int reg = 0; reg < 16; ++reg) { const int rr = rb * 32 + crow(reg, hh); uo[reg] = rr < prow ? US5[(size_t)(tok0 + rr * 8 + t) * 1024 + ch] : 0.f; }
            f32x16 acc = zero16();
#pragma unroll
            for (int kb = 0; kb < 8; ++kb) { bf16x8 a = (bf16x8){0, 0, 0, 0, 0, 0, 0, 0}; if (valid) a = *(const LAS bf16x8*)(U + row * S5_UROW + kb * 16 + 8 * hh); acc = MFMA32(a, mfr[kb], acc); }
#pragma unroll
            for (int kb = 0; kb < 8; ++kb) { const LAS float* hp = H + row * 128 + (((kb * 2 + hh) ^ (row & 15)) << 3); acc = MFMA32(cvt_frag(*(const LAS f32x4*)hp, *(const LAS f32x4*)(hp + 4)), ffr[kb], acc); }
#pragma unroll
            for (int reg = 0; reg < 16; ++reg) { const int rr = rb * 32 + crow(reg, hh);
                if (rr < prow) YP[(size_t)(tok0 + rr * 8 + t) * 1024 + ch] = f2bf(gelu_tanh(acc[reg] + Dv * uo[reg])); }
        }
        __syncthreads();
    }
}

constexpr int VT_STRIDE = 72;
DI float log_sigmoid(float x) { return fminf(x, 0.f) - log1pf(expf(-fabsf(x))); }
DI float conv1(const Params& P, float xm3, float xm2, float xm1, float x0, int col) {
    const float* w = P.in[I_CW]; return siluf_(xm3 * w[col] + xm2 * w[1024 + col] + xm1 * w[2048 + col] + x0 * w[3072 + col] + P.in[I_CB][col]);
}
DI void mlstm_prep(Frame& F, int item) {
    const Params& P = *F.P;
    const int hd = item & 3, c = (item >> 2) % NCH, n = (item >> 2) / NCH;
    const int t0 = c == 0 ? 0 : 16 + 64 * (c - 1), L = c == 0 ? 16 : 64, R0 = n * LP + t0;
    LAS bf16_t* KT = (LAS bf16_t*)F.lds;
    LAS bf16_t* VT = KT + 128 * VT_STRIDE + F.wave * 32 * VT_STRIDE;
    LAS float* wsc = (LAS float*)(F.lds + (128 + 256) * VT_STRIDE * 2);
    const float* ZIF = (const float*)(F.ws + WS_ZIF); const float* QKPRE = (const float*)(F.ws + WS_QKPRE);
    bf16_t* QK = (bf16_t*)(F.ws + WS_QK); const bf16_t* V = (const bf16_t*)(F.ws + WS_HID) + (size_t)MR * 4096;
    const int lane = F.lane, tid = F.tid;
    if (F.wave == 0) { const bool valid = lane < L; const int R = R0 + lane;
        const float ig = valid ? ZIF[(size_t)R * 8 + hd] + P.in[I_MBI][hd] : 0.f;
        const float lf = valid ? log_sigmoid(ZIF[(size_t)R * 8 + 4 + hd] + P.in[I_MBF][hd]) : 0.f;
        float b = lf; for (int o = 1; o < 64; o <<= 1) { const float t = __shfl_up(b, o); if (lane >= o) b += t; }
        const float bL = __shfl(b, L - 1);
        const float a = valid ? bL - b + ig : -INFINITY; const float mloc = wave_max(a);
        wsc[lane] = valid ? __expf(a - mloc) : 0.f;
        if (valid) { ((float*)(F.ws + WS_GB))[(size_t)R * 4 + hd] = b; ((float*)(F.ws + WS_GI))[(size_t)R * 4 + hd] = ig; }
        if (lane == 0) { float* its = (float*)(F.ws + WS_ITS); its[item] = bL; its[NITEM + item] = mloc; }
    }
    __syncthreads();
    { const int ch = tid & 255, col = ch < 128 ? hd * 128 + ch : 512 + hd * 128 + (ch - 128), s0 = (tid >> 8) * 32;
      const float* cw = P.in[I_CW]; const float w0 = cw[col], w1 = cw[1024 + col], w2 = cw[2048 + col], w3 = cw[3072 + col], cb = P.in[I_CB][col];
#pragma unroll 1
      for (int sq = s0; sq < s0 + 32 && sq < L; sq += 16) {
          const float* xp = QKPRE + (size_t)(R0 + sq) * 1024 + col; bf16_t* qo = QK + (size_t)(R0 + sq) * 1024 + col;
          float x[19];
#pragma unroll
          for (int i = 0; i < 19; ++i) x[i] = (t0 + sq - 3 + i >= 0) ? xp[(i - 3) * 1024] : 0.f;
#pragma unroll
          for (int i = 0; i < 16; ++i) {
              float v = siluf_(x[i] * w0 + x[i + 1] * w1 + x[i + 2] * w2 + x[i + 3] * w3 + cb); if (ch < 128) v *= 0.08838834764831845f;
              qo[i * 1024] = f2bf(v);
              if (ch >= 128) KT[(ch - 128) * VT_STRIDE + sq + i] = f2bf(v * wsc[sq + i]); } } }
    { const bool valid = lane < L; const bf16_t* vp = V + (size_t)(R0 + lane) * 1024 + hd * 256 + F.wave * 32;
#pragma unroll
      for (int q = 0; q < 4; ++q) { u32x4 w = (u32x4){0u, 0u, 0u, 0u}; if (valid) w = *(const u32x4*)(vp + q * 8);
          const unsigned ww[4] = {w.x, w.y, w.z, w.w};
#pragma unroll
          for (int j = 0; j < 4; ++j) { VT[(q * 8 + 2 * j) * VT_STRIDE + lane] = (bf16_t)(ww[j] & 0xffffu); VT[(q * 8 + 2 * j + 1) * VT_STRIDE + lane] = (bf16_t)(ww[j] >> 16); } } }
    __syncthreads();
    { const int r31 = lane & 31, hh = lane >> 5, nks = c == 0 ? 1 : 4;
      float* DC = (float*)(F.ws + WS_WFF) + (size_t)item * 32768;
#pragma unroll 1
      for (int nb = 0; nb < 4; ++nb) { f32x16 acc = zero16();
          for (int ks = 0; ks < nks; ++ks) { const bf16x8 a = *(const LAS bf16x8*)(VT + r31 * VT_STRIDE + ks * 16 + 8 * hh), b = *(const LAS bf16x8*)(KT + (nb * 32 + r31) * VT_STRIDE + ks * 16 + 8 * hh); acc = MFMA32(a, b, acc); }
#pragma unroll
          for (int reg = 0; reg < 16; ++reg) DC[(F.wave * 32 + crow(reg, hh)) * 128 + nb * 32 + r31] = acc[reg]; }
      if (tid < 128) { float s = 0.f; for (int q = 0; q < L; ++q) s += bf1(KT[tid * VT_STRIDE + q]); ((float*)(F.ws + WS_DN))[item * 128 + tid] = s; } }
    __syncthreads();
}
DI void mlstm_scan(Frame& F) {
    const Params& P = *F.P;
    const float* its = (const float*)(F.ws + WS_ITS); float* m0s = (float*)(F.ws + WS_ITS) + 2 * NITEM;
    const float* DC = (const float*)(F.ws + WS_WFF); bf16_t* CJ = (bf16_t*)(F.ws + WS_XA);
    const int gid = F.bid * 512 + F.tid;
    if (gid < 16 * 8192) { const int chain = gid >> 13, e4 = gid & 8191, n = chain >> 2, hd = chain & 3;
        f32x4 C = (f32x4){0.f, 0.f, 0.f, 0.f}; float m0 = 0.f;
#pragma unroll 1
        for (int c0 = 0; c0 < NCH; c0 += 11) { f32x4 d[11];
#pragma unroll
            for (int j = 0; j < 11; ++j) d[j] = __builtin_nontemporal_load((const f32x4*)(DC + (size_t)((n * NCH + c0 + j) * 4 + hd) * 32768 + e4 * 4));
#pragma unroll
            for (int j = 0; j < 11; ++j) { const int item = (n * NCH + c0 + j) * 4 + hd;
                const float bL = its[item], ml = its[NITEM + item], mn = fmaxf(bL + m0, ml), dec = __expf(bL + m0 - mn), sc = __expf(ml - mn);
                *(u32x2*)(CJ + (size_t)item * 32768 + e4 * 4) = (u32x2){pk2(C.x, C.y), pk2(C.z, C.w)};
                C = C * dec + d[j] * sc; m0 = mn; } }
        *(f32x4*)(P.out + O_PC + (size_t)chain * 32768 + e4 * 4) = C; }
    if (F.bid == 255) { const int chain = F.tid >> 5, k4 = F.tid & 31, n = chain >> 2, hd = chain & 3;
        const float* DN = (const float*)(F.ws + WS_DN); float* NJ = (float*)(F.ws + WS_NJ);
        f32x4 C = (f32x4){0.f, 0.f, 0.f, 0.f}; float m0 = 0.f;
        for (int c = 0; c < NCH; ++c) { const int item = (n * NCH + c) * 4 + hd;
            const float bL = its[item], ml = its[NITEM + item], mn = fmaxf(bL + m0, ml), dec = __expf(bL + m0 - mn), sc = __expf(ml - mn);
            *(f32x4*)(NJ + item * 128 + k4 * 4) = C; if (k4 == 0) m0s[item] = m0;
            const f32x4 d = *(const f32x4*)(DN + item * 128 + k4 * 4);
            C = C * dec + d * sc; m0 = mn; }
        *(f32x4*)(P.out + O_PN + chain * 128 + k4 * 4) = C; if (k4 == 0) P.out[O_PM + chain] = m0; }
}
DI void out_xtile(const bf16x8 (&kf)[8], const bf16x8 (&qf)[8], int sb, int t, int L, float bmt, const LAS float* sm, const LAS bf16_t* VT, int r31, int hh, f32x16& acc1, float& den1) {
    f32x16 x = zero16();
#pragma unroll
    for (int ks = 0; ks < 8; ++ks) x = MFMA32(kf[ks], qf[ks], x);
#pragma unroll
    for (int reg = 0; reg < 16; ++reg) { const int s = sb * 32 + crow(reg, hh); const float w = (s <= t && s < L) ? __expf(sm[s] + bmt) : 0.f; x[reg] *= w; den1 += x[reg]; }
#pragma unroll
    for (int st = 0; st < 2; ++st) { u32x4 p; p.x = pk2(x[8 * st], x[8 * st + 1]); p.y = pk2(x[8 * st + 2], x[8 * st + 3]); p.z = pk2(x[8 * st + 4], x[8 * st + 5]); p.w = pk2(x[8 * st + 6], x[8 * st + 7]);
        const LAS bf16_t* vv = VT + r31 * VT_STRIDE + sb * 32 + 16 * st + 4 * hh; const u32x2 v0 = *(const LAS u32x2*)vv, v1 = *(const LAS u32x2*)(vv + 8);
        const u32x4 vb = (u32x4){v0.x, v0.y, v1.x, v1.y};
        acc1 = MFMA32(__builtin_bit_cast(bf16x8, p), __builtin_bit_cast(bf16x8, vb), acc1); }
}
constexpr int QS_ROW = 136;
DI void mlstm_out(Frame& F, int item) {
    const int hd = item & 3, c = (item >> 2) % NCH, n = (item >> 2) / NCH;
    const int t0 = c == 0 ? 0 : 16 + 64 * (c - 1), L = c == 0 ? 16 : 64, R0 = n * LP + t0, ntb = c == 0 ? 1 : 2;
    LAS bf16_t* Qs = (LAS bf16_t*)F.lds; LAS bf16_t* Ks = Qs + 64 * QS_ROW;
    LAS bf16_t* VT = Ks + 64 * QS_ROW + F.wave * 32 * VT_STRIDE;
    LAS float* sm = (LAS float*)(F.lds + (2 * 64 * QS_ROW + 256 * VT_STRIDE) * 2) + F.wave * 512;
    const bf16_t* QK = (const bf16_t*)(F.ws + WS_QK); const bf16_t* V = (const bf16_t*)(F.ws + WS_HID) + (size_t)MR * 4096;
    const bf16_t* CJ = (const bf16_t*)(F.ws + WS_XA) + (size_t)item * 32768; const float* NJ = (const float*)(F.ws + WS_NJ) + item * 128;
    float* HU = (float*)(F.ws + WS_US5);
    const int lane = F.lane, r31 = lane & 31, hh = lane >> 5, tid = F.tid;
    const bool valid = lane < L;
    const float m0 = ((const float*)(F.ws + WS_ITS))[2 * NITEM + item];
    bf16x8 cf[8];
#pragma unroll
    for (int ks = 0; ks < 8; ++ks) cf[ks] = *(const bf16x8*)(CJ + (F.wave * 32 + r31) * 128 + ks * 16 + 8 * hh);
#pragma unroll
    for (int i = 0; i < 2; ++i) { const int e = tid + i * 512, row = e >> 4, c16 = e & 15; const bf16_t* src = QK + (size_t)(R0 + row) * 1024 + hd * 128 + c16 * 8;
        const u32x4 q = *(const u32x4*)src, k = *(const u32x4*)(src + 512);
        *(LAS u32x4*)(Qs + row * QS_ROW + c16 * 8) = q; *(LAS u32x4*)(Ks + row * QS_ROW + c16 * 8) = k; }
    { const float b = valid ? ((const float*)(F.ws + WS_GB))[(size_t)(R0 + lane) * 4 + hd] : 0.f, ig = valid ? ((const float*)(F.ws + WS_GI))[(size_t)(R0 + lane) * 4 + hd] : 0.f;
      const float cs = valid ? ig - b : -INFINITY; float pm = cs;
      for (int o = 1; o < 64; o <<= 1) { const float t = __shfl_up(pm, o); if (lane >= o) pm = fmaxf(pm, t); }
      const float bm = -fmaxf(m0, pm);
      sm[lane] = cs; sm[64 + lane] = bm; sm[128 + lane] = __expf(m0 + bm); sm[448 + lane] = __expf(bm - b); sm[256 + lane] = NJ[lane]; sm[320 + lane] = NJ[64 + lane]; }
#pragma unroll
    for (int i = 0; i < 4; ++i) { const int s = 16 * i + (lane >> 2), v8 = (lane & 3) * 8; u32x4 w = (u32x4){0u, 0u, 0u, 0u};
        if (s < L) w = *(const u32x4*)(V + (size_t)(R0 + s) * 1024 + hd * 256 + F.wave * 32 + v8);
        const unsigned ww[4] = {w.x, w.y, w.z, w.w};
#pragma unroll
        for (int j = 0; j < 4; ++j) { VT[(v8 + 2 * j) * VT_STRIDE + s] = (bf16_t)(ww[j] & 0xffffu); VT[(v8 + 2 * j + 1) * VT_STRIDE + s] = (bf16_t)(ww[j] >> 16); } }
    __syncthreads();
#pragma unroll
    for (int tb = 0; tb < 2; ++tb) { if (tb < ntb) {
        const int t = tb * 32 + r31; const float bmt = sm[64 + t];
        bf16x8 qf[8];
#pragma unroll
        for (int ks = 0; ks < 8; ++ks) qf[ks] = *(const LAS bf16x8*)(Qs + t * QS_ROW + ks * 16 + 8 * hh);
        float den2 = 0.f;
#pragma unroll
        for (int ks = 0; ks < 8; ++ks) { const u32x4 w = __builtin_bit_cast(u32x4, qf[ks]); const LAS float* nn = sm + 256 + ks * 16 + 8 * hh;
            den2 += bflo(w.x) * nn[0] + bfhi(w.x) * nn[1] + bflo(w.y) * nn[2] + bfhi(w.y) * nn[3] + bflo(w.z) * nn[4] + bfhi(w.z) * nn[5] + bflo(w.w) * nn[6] + bfhi(w.w) * nn[7]; }
        den2 += __shfl_xor(den2, 32);
        f32x16 acc1 = zero16(), acc2 = zero16(); float den1 = 0.f;
#pragma unroll
        for (int sb = 0; sb < 2; ++sb) { if (sb <= tb) {
            bf16x8 kf[8];
#pragma unroll
            for (int ks = 0; ks < 8; ++ks) kf[ks] = *(const LAS bf16x8*)(Ks + (sb * 32 + r31) * QS_ROW + ks * 16 + 8 * hh);
            out_xtile(kf, qf, sb, t, L, bmt, sm, VT, r31, hh, acc1, den1); } }
#pragma unroll
        for (int ks = 0; ks < 8; ++ks) acc2 = MFMA32(qf[ks], cf[ks], acc2);
        den1 += __shfl_xor(den1, 32);
        { const float den = den1 + sm[128 + t] * den2; if (hh == 0) sm[192 + t] = 1.0f / fmaxf(fabsf(den), sm[448 + t]); }
        LDS_WAIT();
#pragma unroll
        for (int reg = 0; reg < 16; ++reg) { const int tt = tb * 32 + crow(reg, hh);
            if (tt < L) HU[(size_t)(R0 + tt) * 1024 + hd * 256 + F.wave * 32 + r31] = (acc1[reg] + sm[128 + tt] * acc2[reg]) * sm[192 + tt]; }
    } }
    __syncthreads();
}
DI void mlstm_sample(Frame& F, int chain) {
    const Params& P = *F.P;
    const int n = chain >> 2, hd = chain & 3, R0 = PROWS + n * 8;
    LAS float* qs = (LAS float*)F.lds;
    LAS float* ks = qs + 1024;
    LAS float* vs = ks + 1024;
    LAS float* ss = vs + 2048;
    LAS float* ga = ss + 64;
    const float* ZIF = (const float*)(F.ws + WS_ZIF); const float* QKPRE = (const float*)(F.ws + WS_QKPRE);
    const bf16_t* V = (const bf16_t*)(F.ws + WS_HID) + (size_t)MR * 4096; float* HU = (float*)(F.ws + WS_US5);
    const int tid = F.tid, lane = F.lane;
    const float m0 = P.in[I_MM][chain];
    if (F.wave == 0) { const bool valid = lane < 8; const int R = R0 + lane;
        const float ig = valid ? ZIF[(size_t)R * 8 + hd] + P.in[I_MBI][hd] : 0.f;
        const float lf = valid ? log_sigmoid(ZIF[(size_t)R * 8 + 4 + hd] + P.in[I_MBF][hd]) : 0.f;
        float b = lf; for (int o = 1; o < 64; o <<= 1) { const float t = __shfl_up(b, o); if (lane >= o) b += t; }
        const float cs = valid ? ig - b : -INFINITY; float pm = cs;
        for (int o = 1; o < 64; o <<= 1) { const float t = __shfl_up(pm, o); if (lane >= o) pm = fmaxf(pm, t); }
        const float bm = -fmaxf(m0, pm), mt = b - bm;
        const float bL = __shfl(b, 7), mnew = __shfl(mt, 7);
        if (valid) { ga[lane] = __expf(bL - b + ig - mnew); ga[8 + lane] = cs; ga[16 + lane] = bm; ga[24 + lane] = __expf(m0 + bm); ga[32 + lane] = __expf(-mt); }
        if (lane == 0) { ga[56] = __expf(bL + m0 - mnew); P.out[O_SM + chain] = mnew; }
    }
    for (int e = tid; e < 2048; e += 512) { const int s = e >> 8, ch = e & 255, col = ch < 128 ? hd * 128 + ch : 512 + hd * 128 + (ch - 128);
        float x[4];
#pragma unroll
        for (int j = 0; j < 4; ++j) { const int t = s - 3 + j; x[j] = t >= 0 ? QKPRE[(size_t)(R0 + t) * 1024 + col] : P.in[I_MCONV][((size_t)n * 3 + (3 + t)) * 1024 + col]; }
        const float v = conv1(P, x[0], x[1], x[2], x[3], col);
        if (ch < 128) qs[s * 128 + ch] = v * 0.08838834764831845f; else ks[s * 128 + ch - 128] = v; }
    for (int e = tid; e < 2048; e += 512) { const int s = e >> 8, v = e & 255; vs[e] = bf1(V[(size_t)(R0 + s) * 1024 + hd * 256 + v]); }
    __syncthreads();
    if (F.wave == 0) { const int t = lane >> 3, s = lane & 7; float d = 0.f;
        if (s <= t) { for (int k = 0; k < 128; ++k) d += qs[t * 128 + k] * ks[s * 128 + k]; d *= __expf(ga[8 + s] + ga[16 + t]); }
        ss[lane] = d; }
    else if (F.wave == 1) { const int t = lane >> 3, part = lane & 7; float d = 0.f;
        for (int k = part * 16; k < part * 16 + 16; ++k) d += P.in[I_MN][chain * 128 + k] * qs[t * 128 + k];
        d += __shfl_xor(d, 1); d += __shfl_xor(d, 2); d += __shfl_xor(d, 4); if (part == 0) ga[40 + t] = d; }
    __syncthreads();
    if (tid < 8) { float den = 0.f; for (int s = 0; s < 8; ++s) den += ss[tid * 8 + s]; den += ga[24 + tid] * ga[40 + tid]; ga[48 + tid] = 1.0f / fmaxf(fabsf(den), ga[32 + tid]); }
    __syncthreads();
    { const float decay = ga[56];
      const float* C0 = P.in[I_MC] + (size_t)chain * 32768; float* Cn = P.out + O_SC + (size_t)chain * 32768;
      { const int r31 = lane & 31, hh = lane >> 5; f32x16 acc = zero16();
        f32x4 ca[8], cb[8];
#pragma unroll
        for (int kq = 0; kq < 8; ++kq) { const float* cp = C0 + (F.wave * 32 + r31) * 128 + kq * 16 + 8 * hh; ca[kq] = *(const f32x4*)cp; cb[kq] = *(const f32x4*)(cp + 4); }
#pragma unroll
        for (int kq = 0; kq < 8; ++kq) { f32x4 qa = (f32x4){0.f, 0.f, 0.f, 0.f}, qb = qa;
            if (r31 < 8) { const LAS float* qp = qs + r31 * 128 + kq * 16 + 8 * hh; qa = *(const LAS f32x4*)qp; qb = *(const LAS f32x4*)(qp + 4); }
            acc = MFMA32(cvt_frag(ca[kq], cb[kq]), cvt_frag(qa, qb), acc); }
        if (r31 < 8) { const int t = r31; const float it = ga[24 + t], iv = ga[48 + t];
#pragma unroll
            for (int reg = 0; reg < 16; ++reg) { const int v = F.wave * 32 + crow(reg, hh); float sv = 0.f;
#pragma unroll
                for (int s = 0; s < 8; ++s) sv += ss[t * 8 + s] * vs[s * 256 + v];
                HU[(size_t)(R0 + t) * 1024 + hd * 256 + v] = (sv + it * acc[reg]) * iv; } } }
      { const int k4 = tid & 31, vr = tid >> 5;
        f32x4 kr[8];
#pragma unroll
        for (int t = 0; t < 8; ++t) kr[t] = *(const LAS f32x4*)(ks + t * 128 + k4 * 4);
#pragma unroll 1
        for (int p0 = 0; p0 < 16; p0 += 4) { f32x4 c0s[4];
#pragma unroll
            for (int q = 0; q < 4; ++q) c0s[q] = __builtin_nontemporal_load((const f32x4*)(C0 + ((p0 + q) * 16 + vr) * 128 + k4 * 4));
#pragma unroll
            for (int q = 0; q < 4; ++q) { const int v = (p0 + q) * 16 + vr; f32x4 cn = c0s[q] * decay;
#pragma unroll
                for (int s = 0; s < 8; ++s) cn += kr[s] * (ga[s] * vs[s * 256 + v]);
                __builtin_nontemporal_store(cn, (f32x4*)(Cn + v * 128 + k4 * 4)); } } }
      if (tid < 128) { float nn = decay * P.in[I_MN][chain * 128 + tid]; for (int s = 0; s < 8; ++s) nn += ga[s] * ks[s * 128 + tid]; P.out[O_SN + chain * 128 + tid] = nn; } }
    __syncthreads();
}
DI void yml_row(Frame& F, int r) {
    const float* HU = (const float*)(F.ws + WS_US5) + (size_t)r * 1024; const bf16_t* SG = (const bf16_t*)(F.ws + WS_SIGO) + (size_t)r * 1024;
    u32x2* o = (u32x2*)((bf16_t*)(F.ws + WS_QKPRE) + (size_t)r * 1024);
    if (r >= NTOK) { for (int j = 0; j < 4; ++j) o[64 * j + F.lane] = (u32x2){0u, 0u}; return; }
#pragma unroll
    for (int j = 0; j < 4; ++j) { const f32x4 v = ((const f32x4*)HU)[64 * j + F.lane]; const float s = wave_sum((v.x * v.x + v.y * v.y) + (v.z * v.z + v.w * v.w));
        const float rn = rsqrtf(s * (1.0f / 256.0f) + EPS); const f32x4 g = ((const f32x4*)F.P->in[I_MNORM])[64 * j + F.lane]; const u32x2 sg = ((const u32x2*)SG)[64 * j + F.lane];
        o[64 * j + F.lane] = (u32x2){pk2(v.x * rn * g.x * bflo(sg.x), v.y * rn * g.y * bfhi(sg.x)), pk2(v.z * rn * g.z * bflo(sg.y), v.w * rn * g.w * bfhi(sg.y))}; }
}


DI int grab_item(Frame& F, unsigned* cnt) {
    volatile LAS int* slot = (volatile LAS int*)(F.lds + 288 * 512 + 768);
    if (F.tid == 0) *slot = (int)__hip_atomic_fetch_add(cnt, 1u, __ATOMIC_RELAXED, __HIP_MEMORY_SCOPE_AGENT);
    __syncthreads();
    const int v = *slot;
    __syncthreads();
    return v;
}

#define XB_TMO      128
#define XB_XCNT(j)  (256  + 64 * (j))
#define XB_XSUB(j)  (1280 + 64 * (j))
#define XB_XGEN(j)  (2304 + 64 * (j))
#define XB_TOP      3328
#define XB_TOPGEN   3392
#define XCD_BAR_WORDS 3456
#define XB_SPIN_CAP (1u << 22)
DI unsigned xb_ld(unsigned* p)              { return __hip_atomic_load(p, __ATOMIC_RELAXED, __HIP_MEMORY_SCOPE_AGENT); }
DI unsigned xb_add(unsigned* p, unsigned v) { return __hip_atomic_fetch_add(p, v, __ATOMIC_RELAXED, __HIP_MEMORY_SCOPE_AGENT); }
DI unsigned xb_xcc_id() { return (unsigned)__builtin_amdgcn_s_getreg((3 << 11) | 20) & 0xFu; }
#define XB_SPIN(cond, bar) do { unsigned _sp = 0; while (cond) { __builtin_amdgcn_s_sleep(1); \
    if ((++_sp & 255u) == 0u) { if (xb_ld(&(bar)[XB_TMO])) break; if (_sp > XB_SPIN_CAP) { atomicAdd(&(bar)[XB_TMO], 1u); break; } } } } while (0)
struct XcdBarrier { unsigned* bar; unsigned x; volatile LAS unsigned* st; };
DI XcdBarrier xcd_barrier_post(unsigned* bar, volatile LAS unsigned* st) {
    XcdBarrier b; b.bar = bar; b.x = xb_xcc_id(); b.st = st;
    if (threadIdx.x == 0) (void)xb_add(&bar[XB_XCNT(b.x)], 1u);
    return b;
}
DI void xcd_barrier_complete(unsigned* bar, unsigned x, unsigned& nloc, unsigned& nx) {
    const unsigned G = gridDim.x * gridDim.y * gridDim.z;
    unsigned sum, cnt, mine, sp = 0u;
    for (;;) {
        sum = 0u; cnt = 0u; mine = 0u;
#pragma unroll
        for (unsigned j = 0; j < 16; ++j) { const unsigned c = xb_ld(&bar[XB_XCNT(j)]); sum += c; cnt += (c > 0u) ? 1u : 0u; mine = (j == x) ? c : mine; }
        if (sum == G) break;
        __builtin_amdgcn_s_sleep(1);
        if ((++sp & 255u) == 0u) { if (xb_ld(&bar[XB_TMO])) break; if (sp > XB_SPIN_CAP) { atomicAdd(&bar[XB_TMO], 1u); break; } }
    }
    nloc = mine > 0u ? mine : 1u; nx = cnt > 0u ? cnt : 1u;
}
DI void xcd_barrier(const XcdBarrier& b) {
    asm volatile("s_waitcnt vmcnt(0)" ::: "memory");
    __syncthreads();
    if (threadIdx.x == 0) {
        unsigned* bar = b.bar;
        __builtin_amdgcn_s_waitcnt(0);
        unsigned nloc = b.st[0], nx = b.st[1];
        if (nloc == 0u) { xcd_barrier_complete(bar, b.x, nloc, nx); b.st[0] = nloc; b.st[1] = nx; }
        const unsigned old = xb_add(&bar[XB_XSUB(b.x)], 1u);
        const unsigned gen = old / nloc;
        if (old + 1u == (gen + 1u) * nloc) {
            __builtin_amdgcn_fence(__ATOMIC_RELEASE, "agent");
            asm volatile("s_waitcnt vmcnt(0)" ::: "memory");
            const unsigned og = xb_add(&bar[XB_TOP], 1u);
            const unsigned tg = og / nx;
            if (og + 1u == (tg + 1u) * nx) xb_add(&bar[XB_TOPGEN], 1u);
            else XB_SPIN(xb_ld(&bar[XB_TOPGEN]) == tg, bar);
            __builtin_amdgcn_fence(__ATOMIC_ACQUIRE, "agent");
            xb_add(&bar[XB_XGEN(b.x)], 1u);
            asm volatile("s_waitcnt vmcnt(0)" ::: "memory");
        } else {
            XB_SPIN(xb_ld(&bar[XB_XGEN(b.x)]) == gen, bar);
            __builtin_amdgcn_fence(__ATOMIC_ACQUIRE, "agent");
            asm volatile("s_waitcnt vmcnt(0)" ::: "memory");
        }
    }
    __syncthreads();
}

__global__ void __launch_bounds__(512, 2) fwd_kernel(Params prm) {
    extern __shared__ __attribute__((aligned(16))) unsigned char lds_raw[];
    cg::grid_group grid = cg::this_grid();
    Frame F; F.lds = (LAS unsigned char*)lds_raw; F.P = &prm; F.ws = prm.ws; F.tid = threadIdx.x; F.lane = F.tid & 63; F.wave = __builtin_amdgcn_readfirstlane(F.tid >> 6); F.G = gridDim.x; F.bid = blockIdx.x;
    const Params& P = prm;
    unsigned char* ws = prm.ws;
    const int gw = F.bid * 8 + F.wave, NGW = F.G * 8;
    const int lo = prm.ph_lo, hi = prm.ph_hi;
#define IN(k) (lo <= (k) && (k) < hi)
#define SEAM(k) do { if (IN(k) && IN((k) + 1)) { xcd_barrier(xbar); } } while (0)
    volatile LAS unsigned* xst = (volatile LAS unsigned*)(F.lds + 288 * 512 + 512);
    if (F.tid < 2) xst[F.tid] = 0u;
    __syncthreads();
    XcdBarrier xbar; xbar.bar = (unsigned*)(ws + WS_BAR); xbar.x = 0; xbar.st = xst;
    if (hi - lo > 1) xbar = xcd_barrier_post((unsigned*)(ws + WS_BAR), xst);
    if (lo > 4096) grid.sync();
#ifndef DUP_MASK
#define DUP_MASK 0
#endif
#define PH(k) for (int rep_ = 0; rep_ < (IN(k) ? 1 + ((DUP_MASK >> (k)) & 1) : 0); ++rep_)
    bf16_t* W1 = (bf16_t*)(ws + WS_WFF); bf16_t* XA = (bf16_t*)(ws + WS_XA); bf16_t* HID = (bf16_t*)(ws + WS_HID); float* H = (float*)(ws + WS_H);
    float* SSQ = (float*)(ws + WS_SSQ);

    PH(0) {
        LAS float* scr = (LAS float*)(F.lds + F.wave * 8704);
        for (int i = F.bid * 512 + F.tid; i < 3 * MR; i += F.G * 512) SSQ[i] = 0.f;
        if (F.bid == 0 && F.tid < 4) ((unsigned*)(ws + WS_CNT))[F.tid * 64] = 0u;
        for (int i = F.bid * 512 + F.tid; i < (MR - NTOK) * 1024 / 2; i += F.G * 512) ((unsigned*)((bf16_t*)(ws + WS_YS5P) + (size_t)NTOK * 1024))[i] = 0u;
        for (int it = gw; it < 32 * 264; it += NGW) { const int kb = it / 264, nb = it - kb * 264, d0 = nb * 32;
            int src = d0, nv = 32; if (d0 >= 8192) { src = 4096; nv = d0 == 8192 ? 8 : 0; } else if (d0 >= 4096) src = d0 + 8;
            tr_item(P.in[I_WIN], 8200, src, nv, (bf16_t*)(ws + WS_WIN), D, d0, kb * 64, scr, F.lane); }
        for (int it = gw; it < 16 * 32; it += NGW) { const int kb = it / 32, nb = it - kb * 32; tr_item(P.in[I_WGLU], 1024, nb * 32, 32, (bf16_t*)(ws + WS_WGLU), 1024, nb * 32, kb * 64, scr, F.lane); }
        for (int it = gw; it < 16 * 64; it += NGW) { const int kb = it / 64, nb = it - kb * 64; tr_item(P.in[I_WBS], 2048, nb * 32, 32, (bf16_t*)(ws + WS_WBS), 1024, nb * 32, kb * 64, scr, F.lane);
            tr_item(P.in[I_WBM], 2048, nb * 32, 32, (bf16_t*)(ws + WS_WBM), 1024, nb * 32, kb * 64, scr, F.lane); }
        for (int it = gw; it < 32 * 64; it += NGW) { const int kb = it / 64, nb = it - kb * 64; tr_item(P.in[I_WOUT], 2048, nb * 32, 32, (bf16_t*)(ws + WS_WOUT), 2048, nb * 32, kb * 64, scr, F.lane); }
        for (int it = gw; it < FFN_ITEMS; it += NGW) ffn_conv_item(P.in[I_F1G], P.in[I_F1U], P.in[I_F1D], W1, FFN_ITEMS - 1 - it, scr, F.lane);
        for (int r = gw; r < MR; r += NGW) rms_row(F, r, P.in[I_F1N], XA);
    }
    SEAM(0);
    PH(1) { pg8::Gemm g{XA, XA, W1, W1, D}; pg8::Order S; S.init(MR, 2 * DFF, F.G, F.bid, 1, 2); EpiSwiglu E{HID, nullptr}; pg8::gemm_phase(F.lds, g, S, E); }
    SEAM(1);
    PH(2) { pg8::Gemm g{HID, HID, W1 + (size_t)2 * DFF * D, W1 + (size_t)2 * DFF * D, DFF}; pg8::Order S; S.init(MR, D, F.G, F.bid, 1, 4);
        EpiResid<0> E{&prm}; pg8::gemm_phase(F.lds, g, S, E); }
    SEAM(2);
    PH(3) { const bf16_t* W = (const bf16_t*)(ws + WS_WIN); pg8::Gemm g{XA, XA, W, W, D}; pg8::Order S; S.init(MR, NIN, F.G, F.bid, 1, 1);
        EpiWin E{(float*)(ws + WS_US5), (float*)(ws + WS_QKPRE), HID + (size_t)MR * 4096, (bf16_t*)(ws + WS_SIGO), HID, (float*)(ws + WS_ZIF), SSQ}; pg8::gemm_phase(F.lds, g, S, E);
        if (F.bid >= 197) { s5_precompute(F, F.bid - 197); if (F.bid - 197 + 59 < 64) s5_precompute(F, F.bid - 197 + 59); } }
    SEAM(3);
    PH(4) {
        for (;;) { const int it = grab_item(F, (unsigned*)(ws + WS_CNT)); if (it >= NITEM + 320) break; if (it < 320) s5_item(F, it); else mlstm_prep(F, it - 320); }
        const float* QKPRE = (const float*)(ws + WS_QKPRE);
        for (int i = F.bid * 512 + F.tid; i < (NB + NS) * 3 * 1024; i += F.G * 512) { const int col = i & 1023, rr = i >> 10, j = rr % 3, b = rr / 3;
            if (b < NB) P.out[O_PCONV + ((size_t)b * 3 + j) * 1024 + col] = QKPRE[(size_t)(b * LP + LP - 3 + j) * 1024 + col];
            else P.out[O_SCONV + ((size_t)(b - NB) * 3 + j) * 1024 + col] = QKPRE[(size_t)(PROWS + (b - NB) * 8 + 5 + j) * 1024 + col]; }
    }
    SEAM(4);
    PH(5) mlstm_scan(F);
    SEAM(5);
    PH(6) {
        for (;;) { const int it = grab_item(F, (unsigned*)(ws + WS_CNT) + 64); if (it >= NITEM + NS * 4) break;
            if (it < NITEM) mlstm_out(F, it); else mlstm_sample(F, it - NITEM); }
        { LAS float* scr = (LAS float*)(F.lds + F.wave * 8704);
          for (;;) { const int it = grab_item(F, (unsigned*)(ws + WS_CNT) + 128); if (it >= FFN_ITEMS / 8) break;
              ffn_conv_item(P.in[I_F2G], P.in[I_F2U], P.in[I_F2D], W1, it * 8 + F.wave, scr, F.lane); } }
    }
    SEAM(6);
    PH(7) {
        bf16_t* YML = (bf16_t*)(ws + WS_QKPRE); bf16_t* YS5 = YML + (size_t)MR * 1024;
        const bf16_t* W = (const bf16_t*)(ws + WS_WGLU); const bf16_t* YP = (const bf16_t*)(ws + WS_YS5P);
        pg8::Gemm g{YP, YP, W, W, 1024}; pg8::Order S; S.init(MR, 1024, F.G, F.bid, 1, 1); EpiGlu E{YP, YS5}; pg8::gemm_phase(F.lds, g, S, E);
        const int nidle = F.G - 148;
        if (F.bid >= 148) for (int r = (F.bid - 148) * 8 + F.wave; r < MR; r += nidle * 8) yml_row(F, r);
    }
    SEAM(7);
    PH(8) { const bf16_t* YML = (const bf16_t*)(ws + WS_QKPRE); const bf16_t* YS5 = YML + (size_t)MR * 1024;
        pg8::Gemm g{YS5, YML, (const bf16_t*)(ws + WS_WBS), (const bf16_t*)(ws + WS_WBM), 1024}; pg8::Order S; S.init(MR, D, F.G, F.bid, 2, 4);
        EpiBranch E{HID, (bf16_t*)(ws + WS_US5)}; pg8::gemm_phase(F.lds, g, S, E); }
    SEAM(8);
    PH(9) { const bf16_t* MG = (const bf16_t*)(ws + WS_US5); const bf16_t* W = (const bf16_t*)(ws + WS_WOUT); pg8::Gemm g{MG, MG, W, W, D}; pg8::Order S; S.init(MR, D, F.G, F.bid, 1, 4);
        EpiResid<1> E{&prm}; pg8::gemm_phase(F.lds, g, S, E); }
    SEAM(9);
    PH(10) { pg8::Gemm g{XA, XA, W1, W1, D}; pg8::Order S; S.init(MR, 2 * DFF, F.G, F.bid, 1, 2); EpiSwiglu E{HID, SSQ + MR}; pg8::gemm_phase(F.lds, g, S, E); }
    SEAM(10);
    PH(11) { pg8::Gemm g{HID, HID, W1 + (size_t)2 * DFF * D, W1 + (size_t)2 * DFF * D, DFF}; pg8::Order S; S.init(MR, D, F.G, F.bid, 1, 4);
        EpiResid<2> E{&prm}; pg8::gemm_phase(F.lds, g, S, E); }
    SEAM(11);
    PH(12) {
        for (int r = gw; r < NTOK; r += NGW) { float* o;
            if (r < PROWS) { const int b = r / LP, t = r - b * LP; if (t < 16) continue; o = P.out + O_YP + ((size_t)b * 2048 + (t - 16)) * D; } else o = P.out + O_YS + (size_t)(r - PROWS) * D;
            const float rs = rsqrtf(SSQ[2 * MR + r] * (1.0f / D) + EPS); const f32x4* h = (const f32x4*)(H + (size_t)r * D); const f32x4* gn = (const f32x4*)P.in[I_FINN];
#pragma unroll
            for (int j = 0; j < 8; ++j) __builtin_nontemporal_store(__builtin_nontemporal_load(h + 64 * j + F.lane) * rs * gn[64 * j + F.lane], (f32x4*)o + 64 * j + F.lane); }
    }
#undef IN
#undef SEAM
}

#ifndef N_LAUNCH_SPLIT
#define N_LAUNCH_SPLIT 0
#endif
#ifndef LAUNCH_LIST
#define LAUNCH_LIST {0, 1, 2, 3, 4, 5, 6, 7, 8, 9, 10, 11, 12}
#endif
extern "C" void kernel_launch(void* const* d_in, const int* in_sizes, int n_in, void* d_out, int out_size, void* d_ws, size_t ws_size, hipStream_t stream) {
    static int grid = 0;
    if (grid == 0) {
        if (n_in != 37 || (size_t)out_size != O_END || ws_size < WS_END) { fprintf(stderr, "kernel_launch: unexpected shapes (n_in %d, out %d, ws %zu, need %zu)\n", n_in, out_size, ws_size, (size_t)WS_END); grid = -1; return; }
        int dev = 0, cus = 0, per_cu = 0;
        hipGetDevice(&dev); hipDeviceGetAttribute(&cus, hipDeviceAttributeMultiprocessorCount, dev);
        if (hipFuncSetAttribute((const void*)fwd_kernel, hipFuncAttributeMaxDynamicSharedMemorySize, LDS_BYTES) != hipSuccess) { fprintf(stderr, "kernel_launch: hipFuncSetAttribute failed\n"); grid = -1; return; }
        if (hipOccupancyMaxActiveBlocksPerMultiprocessor(&per_cu, (const void*)fwd_kernel, 512, LDS_BYTES) != hipSuccess || per_cu < 1) per_cu = 1;
        (void)hipGetLastError();
        grid = cus;
    }
    if (grid < 0) return;
    Params p{};
    for (int i = 0; i < 37; ++i) p.in[i] = (const float*)d_in[i];
    p.out = (float*)d_out; p.ws = (unsigned char*)d_ws;
#if N_LAUNCH_SPLIT
    { const int plist[] = LAUNCH_LIST; for (int k : plist) { p.ph_lo = k; p.ph_hi = k + 1; hipLaunchKernelGGL(fwd_kernel, dim3(grid), dim3(512), LDS_BYTES, stream, p); } }
#else
    p.ph_lo = 0; p.ph_hi = 13;
    (void)hipMemsetAsync((char*)d_ws + WS_BAR, 0, 16384, stream);
    void* args[] = {&p};
    hipError_t e = hipLaunchCooperativeKernel((const void*)fwd_kernel, dim3(grid), dim3(512), args, LDS_BYTES, stream);
    if (e != hipSuccess) fprintf(stderr, "cooperative launch failed: %s (grid %d)\n", hipGetErrorString(e), grid);
#endif
}
```

```cpp
#include <hip/hip_runtime.h>
#include <hip/hip_cooperative_groups.h>
#include <cstdio>
#include <cstdint>
namespace cg = cooperative_groups;

#define LAS __attribute__((address_space(3)))
typedef unsigned short bf16_t;
typedef short bf16x8 __attribute__((ext_vector_type(8)));
typedef float f32x2 __attribute__((ext_vector_type(2)));
typedef float f32x4 __attribute__((ext_vector_type(4)));
typedef float f32x16 __attribute__((ext_vector_type(16)));
typedef unsigned u32x4 __attribute__((ext_vector_type(4)));
typedef unsigned u32x2 __attribute__((ext_vector_type(2)));
#define DI __device__ __forceinline__
#define LDS_WAIT() asm volatile("s_waitcnt lgkmcnt(0)" ::: "memory")

constexpr int D = 2048, DFF = 5632, NB = 4, LP = 2064, NS = 128, LS = 8;
constexpr int PROWS = NB * LP;
constexpr int NTOK = PROWS + NS * LS;
constexpr int MR = 9472;
constexpr int NIN = 8448;
constexpr int NCH = 33;
constexpr int NITEM = NB * NCH * 4;
constexpr float EPS = 1e-6f;

constexpr size_t AL(size_t x) { return (x + 255) & ~(size_t)255; }
constexpr size_t WS_SSQ = 0;
constexpr size_t WS_BAR = AL(WS_SSQ + 3 * MR * 4);
constexpr size_t WS_CNT = AL(WS_BAR + 16384);
constexpr size_t WS_ZIF = AL(WS_CNT + 4 * 256);
constexpr size_t WS_GB = AL(WS_ZIF + MR * 8 * 4);
constexpr size_t WS_GI = AL(WS_GB + MR * 4 * 4);
constexpr size_t WS_ITS = AL(WS_GI + MR * 4 * 4);
constexpr size_t WS_DN = AL(WS_ITS + 3 * NITEM * 4);
constexpr size_t WS_NJ = AL(WS_DN + NITEM * 128 * 4);
constexpr size_t WS_A8 = AL(WS_NJ + NITEM * 128 * 4);
constexpr size_t WS_S5M = AL(WS_A8 + 64 * 64 * 2 * 4);
constexpr size_t WFF_BYTES = (size_t)2 * DFF * D * 2 + (size_t)D * DFF * 2;
constexpr size_t WS_WFF = AL(WS_S5M + (size_t)64 * 3 * 16384 * 2);
constexpr size_t WS_WIN = AL(WS_WFF + WFF_BYTES);
constexpr size_t WS_WGLU = AL(WS_WIN + (size_t)NIN * D * 2);
constexpr size_t WS_WBS = AL(WS_WGLU + (size_t)1024 * 1024 * 2);
constexpr size_t WS_WBM = AL(WS_WBS + (size_t)2048 * 1024 * 2);
constexpr size_t WS_WOUT = AL(WS_WBM + (size_t)2048 * 1024 * 2);
constexpr size_t WS_XA = AL(WS_WOUT + (size_t)2048 * 2048 * 2);
constexpr size_t WS_HID = AL(WS_XA + (size_t)MR * D * 2);
constexpr size_t WS_H = AL(WS_HID + (size_t)MR * DFF * 2);
constexpr size_t WS_US5 = AL(WS_H + (size_t)MR * D * 4);
constexpr size_t WS_QKPRE = AL(WS_US5 + (size_t)MR * 1024 * 4);
constexpr size_t WS_SIGO = AL(WS_QKPRE + (size_t)MR * 1024 * 4);
constexpr size_t WS_QK = AL(WS_SIGO + (size_t)MR * 1024 * 2);
constexpr size_t WS_YS5P = AL(WS_QK + (size_t)MR * 1024 * 2);
constexpr size_t WS_END = AL(WS_YS5P + (size_t)MR * 1024 * 2);
static_assert((size_t)NITEM * 32768 * 4 <= WFF_BYTES, "DC overlay");
static_assert((size_t)NITEM * 32768 * 2 <= (size_t)MR * D * 2, "CJ overlay");

constexpr size_t O_YP = 0, O_YS = O_YP + (size_t)NB * 2048 * 2048, O_PS5R = O_YS + (size_t)NS * LS * 2048, O_PS5I = O_PS5R + NB * 4096,
                 O_PC = O_PS5I + NB * 4096, O_PN = O_PC + (size_t)NB * 4 * 32768, O_PM = O_PN + NB * 4 * 128, O_PCONV = O_PM + NB * 4,
                 O_SS5R = O_PCONV + NB * 3 * 1024, O_SS5I = O_SS5R + (size_t)NS * 4096, O_SC = O_SS5I + (size_t)NS * 4096,
                 O_SN = O_SC + (size_t)NS * 4 * 32768, O_SM = O_SN + NS * 4 * 128, O_SCONV = O_SM + NS * 4, O_END = O_SCONV + NS * 3 * 1024;

constexpr int LDS_BYTES = 288 * 512 + 1024;

DI unsigned pk2(float lo, float hi) {
    typedef __bf16 bf2 __attribute__((ext_vector_type(2)));
    f32x2 v = {lo, hi}; bf2 b = __builtin_convertvector(v, bf2); return __builtin_bit_cast(unsigned, b);
}
DI bf16x8 cvt_frag(f32x4 a, f32x4 b) { u32x4 w; w.x = pk2(a.x, a.y); w.y = pk2(a.z, a.w); w.z = pk2(b.x, b.y); w.w = pk2(b.z, b.w); return __builtin_bit_cast(bf16x8, w); }
DI float bflo(unsigned w) { return __uint_as_float(w << 16); }
DI float bfhi(unsigned w) { return __uint_as_float(w & 0xffff0000u); }
DI float bf1(bf16_t v) { return __uint_as_float(((unsigned)v) << 16); }
DI bf16_t f2bf(float f) { return (bf16_t)(pk2(f, 0.f) & 0xffffu); }
DI float sigmoidf_(float x) { return __builtin_amdgcn_rcpf(1.0f + __expf(-x)); }
DI float siluf_(float x) { return x * sigmoidf_(x); }
DI float gelu_tanh(float x) { const float u = 0.7978845608028654f * (x + 0.044715f * x * x * x); return x * sigmoidf_(2.0f * u); }
DI int crow(int reg, int h) { return (reg & 3) + 8 * (reg >> 2) + 4 * h; }
#define MFMA32(a, b, c) __builtin_amdgcn_mfma_f32_32x32x16_bf16((a), (b), (c), 0, 0, 0)
DI f32x16 zero16() { f32x16 z; for (int i = 0; i < 16; ++i) z[i] = 0.f; return z; }
DI float wave_max(float v) { for (int o = 1; o < 64; o <<= 1) v = fmaxf(v, __shfl_xor(v, o)); return v; }
DI float wave_sum(float v) { for (int o = 1; o < 64; o <<= 1) v += __shfl_xor(v, o); return v; }

namespace pg8 {
constexpr int BM = 256, BK = 64, HALF = 128, HTB = HALF * BK * 2, STAGE_BYTES = 8 * HTB, NXCD = 8, WGM = 8;
DI int lds_byte(int r, int c) { const int st = (r >> 4) * 2 + (c >> 5), rr = r & 15, cc = c & 31, ob = rr * 64 + cc * 2; return st * 1024 + (ob ^ (((ob >> 9) & 1) << 5)); }
DI void stage_rc(int b, int& R, int& C) { const int st = b / 1024, sb = b % 1024, swz = sb ^ (((sb >> 9) & 1) << 5); R = (st >> 1) * 16 + swz / 64; C = (st & 1) * 32 + (swz % 64) / 2; }
DI int perm32(int rho) { const int n = rho >> 4, i = rho & 15; return 8 * (i >> 2) + 4 * n + (i & 3); }
struct Unit { int pm, pn, sub, mask; };
struct Gemm { const bf16_t* A0; const bf16_t* A1; const bf16_t* B0; const bf16_t* B1; int K; };
struct Order {
    int nM, nN, nwg, G, c, nsub, full, R, parts;
    DI void init(int M, int N, int G_, int c_, int nsub_, int maxparts) { nM = M / BM; nN = N / BM; nwg = nM * nN; G = G_; c = c_; nsub = nsub_;
        full = nwg / G; R = nwg - full * G; parts = (R > 0 && 4 * R <= G && maxparts >= 4) ? 4 : ((R > 0 && 2 * R <= G && maxparts >= 2) ? 2 : 1); }
    DI void tile(int wgid, Unit& u) const {
        { const int q = nwg / NXCD, r = nwg % NXCD, xcd = wgid % NXCD, off = wgid / NXCD; wgid = (xcd < r ? xcd * (q + 1) : r * (q + 1) + (xcd - r) * q) + off; }
        const int nig = WGM * nN, gid = wgid / nig, fm = gid * WGM, gsz = (nM - fm) < WGM ? (nM - fm) : WGM;
        u.pm = fm + ((wgid % nig) % gsz); u.pn = (wgid % nig) / gsz; }
    DI bool next(int i, Unit& u) const {
        const int ti = i / nsub; u.sub = i - ti * nsub; u.mask = 15;
        if (ti < full || parts < 2) { const long L = (long)ti * G + c; if (L >= nwg) return false; tile((int)L, u); return true; }
        if (ti > full || c >= R * parts) return false;
        const int j = c / parts, part = c - j * parts; tile(full * G + j, u);
        u.mask = parts == 4 ? (1 << part) : (part ? 12 : 3); return true;
    }
};
template <class Epi>
DI void gemm_phase(LAS unsigned char* lds, const Gemm g, const Order S, const Epi E) {
    const int tid = threadIdx.x, wid = __builtin_amdgcn_readfirstlane(tid >> 6), lane = tid & 63, wr = wid >> 2, wc = wid & 3, fr = lane & 15, fq = lane >> 4;
    const int K = g.K, nt = K / BK;
    unsigned voffA[2], voffB[2];
#pragma unroll
    for (int i = 0; i < 2; ++i) { int R, C; stage_rc(tid * 16 + i * 8192, R, C); const int Rb = (R & ~31) + perm32(R & 31);
        voffA[i] = (unsigned)(R * K + C) * 2u; voffB[i] = (unsigned)(Rb * K + C) * 2u; }
    const size_t kstep = (size_t)(BK * 2);
    const size_t hstep = (size_t)HALF * K * 2;
    const size_t tstep = 2 * hstep;
    const unsigned ldsw = (unsigned)wid * 1024u;
    const int aoff = lds_byte(wr * 64 + fr, fq * 8), boff = lds_byte(wc * 32 + fr, fq * 8);
#define PG8_SA(b, h) (((b) * 2 + (h)) * HTB)
#define PG8_SB(b, h) ((4 + (b) * 2 + (h)) * HTB)
#define PG8_STAGE(bufoff, gbase, voff) do { _Pragma("unroll") for (int _i = 0; _i < 2; ++_i) \
        __builtin_amdgcn_global_load_lds((const unsigned*)((const char*)(gbase) + (voff)[_i]), (LAS unsigned*)(lds + (bufoff) + ldsw + _i * 8192), 16, 0, 0); } while (0)
#define PG8_STAGEM(need, bufoff, gbase, voff) do { const bool _n = (need); const char* _b = _n ? (const char*)(gbase) : (const char*)g.A0; _Pragma("unroll") for (int _i = 0; _i < 2; ++_i) \
        __builtin_amdgcn_global_load_lds((const unsigned*)(_b + (_n ? (voff)[_i] : 0u)), (LAS unsigned*)(lds + (bufoff) + ldsw + _i * 8192), 16, 0, 0); } while (0)
#define PG8_LDA(dst, b, h) do { _Pragma("unroll") for (int m = 0; m < 4; ++m) _Pragma("unroll") for (int k = 0; k < 2; ++k) dst[m][k] = *(const LAS bf16x8*)(lds + PG8_SA(b, h) + aoff + m * 2048 + k * 1024); } while (0)
#define PG8_LDB(dst, b, h) do { _Pragma("unroll") for (int n = 0; n < 2; ++n) _Pragma("unroll") for (int k = 0; k < 2; ++k) dst[n][k] = *(const LAS bf16x8*)(lds + PG8_SB(b, h) + boff + n * 2048 + k * 1024); } while (0)
#define PG8_MMA(ai, bj, At, Bt) do { __builtin_amdgcn_s_setprio(1); _Pragma("unroll") for (int m = 0; m < 4; ++m) _Pragma("unroll") for (int n = 0; n < 2; ++n) _Pragma("unroll") for (int k = 0; k < 2; ++k) \
        acc[ai][bj][m][n] = __builtin_amdgcn_mfma_f32_16x16x32_bf16(Bt[n][k], At[m][k], acc[ai][bj][m][n], 0, 0, 0); __builtin_amdgcn_s_setprio(0); } while (0)
#define PG8_WAIT_V(n) asm volatile("s_waitcnt vmcnt(" #n ")" ::: "memory")
#define PG8_WAIT_L(n) asm volatile("s_waitcnt lgkmcnt(" #n ")" ::: "memory")
#define PG8_BAR __builtin_amdgcn_s_barrier()
#define PG8_SCHED __builtin_amdgcn_sched_barrier(0)
    Unit cur, nxt; int ui = 0;
    if (!S.next(0, cur)) return;
    f32x4 acc[2][2][4][2];
#pragma unroll
    for (int a = 0; a < 2; ++a)
#pragma unroll
        for (int b = 0; b < 2; ++b)
#pragma unroll
            for (int m = 0; m < 4; ++m)
#pragma unroll
                for (int n = 0; n < 2; ++n) acc[a][b][m][n] = (f32x4){0.f, 0.f, 0.f, 0.f};
    bf16x8 At[4][2], B0[2][2], B1[2][2];
    const char* cA = (const char*)(cur.sub ? g.A1 : g.A0) + (size_t)cur.pm * tstep; const char* cB = (const char*)(cur.sub ? g.B1 : g.B0) + (size_t)cur.pn * tstep;
    PG8_STAGE(PG8_SB(0, 0), cB, voffB); PG8_STAGE(PG8_SB(0, 1), cB + hstep, voffB); PG8_STAGE(PG8_SA(0, 0), cA, voffA); PG8_STAGE(PG8_SA(0, 1), cA + hstep, voffA);
    if (wr == 1) PG8_BAR;
    PG8_WAIT_V(2); PG8_BAR;
    PG8_STAGE(PG8_SB(1, 0), cB + kstep, voffB); PG8_STAGE(PG8_SA(1, 0), cA + kstep, voffA); PG8_STAGE(PG8_SB(1, 1), cB + hstep + kstep, voffB);
    PG8_WAIT_V(6); PG8_BAR;
    for (;;) {
        const bool has_next = S.next(ui + 1, nxt);
        const char* nA = has_next ? (const char*)(nxt.sub ? g.A1 : g.A0) + (size_t)nxt.pm * tstep : cA; const char* nB = has_next ? (const char*)(nxt.sub ? g.B1 : g.B0) + (size_t)nxt.pn * tstep : cB;
        const int mk = cur.mask;
        for (int t = 0; t < nt; t += 2) {
            const bool last = (t == nt - 2);
            const char* a1 = cA + (size_t)(t + 1) * kstep;
            const char* a2 = last ? nA : cA + (size_t)(t + 2) * kstep; const char* b2 = last ? nB : cB + (size_t)(t + 2) * kstep;
            const char* a3 = a2 + kstep; const char* b3 = b2 + kstep;
            const int mn = (last && has_next) ? nxt.mask : mk;
            PG8_LDB(B0, 0, 0); PG8_LDB(B1, 0, 1); PG8_SCHED; PG8_LDA(At, 0, 0); PG8_STAGEM(mk & 12, PG8_SA(1, 1), a1 + hstep, voffA);
            PG8_WAIT_V(8); PG8_WAIT_L(0); PG8_BAR; if (mk & 1) PG8_MMA(0, 0, At, B0); if (mk & 2) PG8_MMA(0, 1, At, B1); PG8_BAR; PG8_SCHED;
            PG8_LDA(At, 0, 1); PG8_STAGEM(mn & 5, PG8_SB(0, 0), b2, voffB); PG8_STAGEM(mn & 10, PG8_SB(0, 1), b2 + hstep, voffB); PG8_STAGEM(mn & 3, PG8_SA(0, 0), a2, voffA);
            PG8_WAIT_V(8); PG8_WAIT_L(0); PG8_BAR; if (mk & 4) PG8_MMA(1, 0, At, B0); if (mk & 8) PG8_MMA(1, 1, At, B1); PG8_BAR; PG8_SCHED;
            PG8_LDB(B0, 1, 0); PG8_LDB(B1, 1, 1); PG8_SCHED; PG8_LDA(At, 1, 0); PG8_STAGEM(mn & 12, PG8_SA(0, 1), a2 + hstep, voffA);
            PG8_WAIT_V(8); PG8_WAIT_L(0); PG8_BAR; if (mk & 1) PG8_MMA(0, 0, At, B0); if (mk & 2) PG8_MMA(0, 1, At, B1); PG8_BAR; PG8_SCHED;
            PG8_LDA(At, 1, 1); PG8_STAGEM(mn & 5, PG8_SB(1, 0), b3, voffB); PG8_STAGEM(mn & 10, PG8_SB(1, 1), b3 + hstep, voffB); PG8_STAGEM(mn & 3, PG8_SA(1, 0), a3, voffA);
            PG8_WAIT_V(8); PG8_WAIT_L(0); PG8_BAR; if (mk & 4) PG8_MMA(1, 0, At, B0); if (mk & 8) PG8_MMA(1, 1, At, B1); PG8_BAR; PG8_SCHED;
        }
        if (wr == 0) PG8_BAR;
        E(acc, cur, wr, wc, fr, fq);
        if (!has_next) break;
#pragma unroll
        for (int a = 0; a < 2; ++a)
#pragma unroll
            for (int b = 0; b < 2; ++b)
#pragma unroll
                for (int m = 0; m < 4; ++m)
#pragma unroll
                    for (int n = 0; n < 2; ++n) acc[a][b][m][n] = (f32x4){0.f, 0.f, 0.f, 0.f};
        cur = nxt; cA = nA; cB = nB; ++ui;
        if (wr == 1) PG8_BAR;
    }
    PG8_WAIT_V(0);
    PG8_BAR;
#undef PG8_SA
#undef PG8_SB
#undef PG8_STAGE
#undef PG8_STAGEM
#undef PG8_LDA
#undef PG8_LDB
#undef PG8_MMA
#undef PG8_WAIT_V
#undef PG8_WAIT_L
#undef PG8_BAR
#undef PG8_SCHED
}
}
typedef f32x4 AccT[2][2][4][2];

struct Params {
    const float* in[37];
    float* out; unsigned char* ws;
    int ph_lo, ph_hi;
};
enum { I_XP = 0, I_XS, I_S5RE, I_S5IM, I_MC, I_MN, I_MM, I_MCONV, I_META, I_F1N, I_F1G, I_F1U, I_F1D, I_MIXN, I_WIN, I_AR, I_AI, I_LDT, I_BR, I_BI, I_CR, I_CI, I_S5D, I_WGLU,
       I_CW, I_CB, I_MBI, I_MBF, I_MNORM, I_WBS, I_WBM, I_WOUT, I_F2N, I_F2G, I_F2U, I_F2D, I_FINN };

struct Frame {
    LAS unsigned char* lds;
    const Params* P;
    unsigned char* ws;
    int tid, lane, wave, G, bid;
};
DI const float* xrow(const Params& P, int r) {
    if (r < PROWS) { const int b = r / LP, t = r - b * LP; return t < 16 ? P.in[I_META] + (size_t)t * D : P.in[I_XP] + ((size_t)b * 2048 + (t - 16)) * D; }
    if (r < NTOK) return P.in[I_XS] + (size_t)(r - PROWS) * D;
    return nullptr;
}

struct EpiSwiglu {
    bf16_t* HID; const float* ssq;
    DI void operator()(const AccT& acc, const pg8::Unit& u, int wr, int wc, int fr, int fq) const {
        const int row0 = u.pm * 256 + wr * 64 + fr, col0 = u.pn * 128 + wc * 32 + 8 * fq;
        float rsv[8];
#pragma unroll
        for (int q = 0; q < 8; ++q) rsv[q] = ssq ? ssq[row0 + (q >> 2) * 128 + (q & 3) * 16] : 0.f;
#pragma unroll
        for (int ai = 0; ai < 2; ++ai)
#pragma unroll
            for (int m = 0; m < 4; ++m) {
                if (!((u.mask >> (ai * 2)) & 1)) continue;
                const int r = row0 + ai * 128 + m * 16;
                const float rs = ssq ? rsqrtf(rsv[ai * 4 + m] * (1.0f / D) + EPS) : 1.0f;
                float h[8];
#pragma unroll
                for (int n = 0; n < 2; ++n)
#pragma unroll
                    for (int j = 0; j < 4; ++j) h[n * 4 + j] = siluf_(acc[ai][0][m][n][j] * rs) * (acc[ai][1][m][n][j] * rs);
                u32x4 w; w.x = pk2(h[0], h[1]); w.y = pk2(h[2], h[3]); w.z = pk2(h[4], h[5]); w.w = pk2(h[6], h[7]);
                *(u32x4*)(HID + (size_t)r * DFF + col0) = w;
            }
    }
};
template <int MODE> struct EpiResid {
    const Params* P;
    DI void operator()(const AccT& acc, const pg8::Unit& u, int wr, int wc, int fr, int fq) const {
        const bool from_inputs = MODE == 0; const float scale = MODE == 1 ? 1.0f : 0.5f;
        float* const H = (float*)(P->ws + WS_H); float* const ssq = (float*)(P->ws + WS_SSQ) + MODE * MR;
        const float* const gain = MODE == 0 ? P->in[I_MIXN] : (MODE == 1 ? P->in[I_F2N] : nullptr); bf16_t* const Aout = MODE < 2 ? (bf16_t*)(P->ws + WS_XA) : nullptr;
        const int row0 = u.pm * 256 + wr * 64 + fr, col0 = u.pn * 256 + wc * 32 + 8 * fq;
        f32x4 gv[2][2];
#pragma unroll
        for (int bj = 0; bj < 2; ++bj) { gv[bj][0] = (f32x4){1.f, 1.f, 1.f, 1.f}; gv[bj][1] = gv[bj][0]; if (MODE < 2) { gv[bj][0] = *(const f32x4*)(gain + col0 + bj * 128); gv[bj][1] = *(const f32x4*)(gain + col0 + bj * 128 + 4); } }
#pragma unroll
        for (int ai = 0; ai < 2; ++ai) {
            if ((u.mask >> (ai * 2)) & 3) {
            f32x4 rv[4][2][2];
#pragma unroll
            for (int m = 0; m < 4; ++m) { const int r = row0 + ai * 128 + m * 16; const float* res = from_inputs ? xrow(*P, r) : H + (size_t)r * D;
#pragma unroll
                for (int bj = 0; bj < 2; ++bj) { rv[m][bj][0] = (f32x4){0.f, 0.f, 0.f, 0.f}; rv[m][bj][1] = rv[m][bj][0];
                    if (res && ((u.mask >> (ai * 2 + bj)) & 1)) { rv[m][bj][0] = *(const f32x4*)(res + col0 + bj * 128); rv[m][bj][1] = *(const f32x4*)(res + col0 + bj * 128 + 4); } } }
#pragma unroll
            for (int m = 0; m < 4; ++m) {
                const int r = row0 + ai * 128 + m * 16;
                float ss = 0.f;
#pragma unroll
                for (int bj = 0; bj < 2; ++bj) {
                    if ((u.mask >> (ai * 2 + bj)) & 1) {
                    const int c = col0 + bj * 128;
                    const f32x4 v0 = rv[m][bj][0] + acc[ai][bj][m][0] * scale, v1 = rv[m][bj][1] + acc[ai][bj][m][1] * scale;
                    *(f32x4*)(H + (size_t)r * D + c) = v0; *(f32x4*)(H + (size_t)r * D + c + 4) = v1;
                    ss += (v0.x * v0.x + v0.y * v0.y) + (v0.z * v0.z + v0.w * v0.w) + (v1.x * v1.x + v1.y * v1.y) + (v1.z * v1.z + v1.w * v1.w);
                    if (MODE < 2) { const f32x4 g0 = gv[bj][0], g1 = gv[bj][1];
                        u32x4 w; w.x = pk2(v0.x * g0.x, v0.y * g0.y); w.y = pk2(v0.z * g0.z, v0.w * g0.w); w.z = pk2(v1.x * g1.x, v1.y * g1.y); w.w = pk2(v1.z * g1.z, v1.w * g1.w);
                        *(u32x4*)(Aout + (size_t)r * D + c) = w; }
                    }
                }
                ss += __shfl_xor(ss, 16); ss += __shfl_xor(ss, 32);
                if (fq == 0) atomicAdd(ssq + r, ss);
            } }
        }
    }
};
struct EpiWin {
    float* US5; float* QKPRE; bf16_t* V; bf16_t* SIGO; bf16_t* GATES; float* ZIF; const float* ssq;
    DI void operator()(const AccT& acc, const pg8::Unit& u, int wr, int wc, int fr, int fq) const {
        const int row0 = u.pm * 256 + wr * 64 + fr, pn = u.pn, cl = wc * 32 + 8 * fq;
        float rsv[8];
#pragma unroll
        for (int q = 0; q < 8; ++q) rsv[q] = ssq[row0 + (q >> 2) * 128 + (q & 3) * 16];
#pragma unroll
        for (int ai = 0; ai < 2; ++ai)
#pragma unroll
            for (int m = 0; m < 4; ++m) {
                const int r = row0 + ai * 128 + m * 16;
                const float rs = rsqrtf(rsv[ai * 4 + m] * (1.0f / D) + EPS);
#pragma unroll
                for (int bj = 0; bj < 2; ++bj) {
                    const int c = pn * 256 + bj * 128 + cl;
                    f32x4 v0 = acc[ai][bj][m][0] * rs, v1 = acc[ai][bj][m][1] * rs;
                    if (pn < 8) { float* dst = (pn < 4 ? US5 + (size_t)r * 1024 + c : QKPRE + (size_t)r * 1024 + (c - 1024)); *(f32x4*)dst = v0; *(f32x4*)(dst + 4) = v1; }
                    else if (pn < 32) {
                        if (pn >= 12) {
#pragma unroll
                            for (int j = 0; j < 4; ++j) { v0[j] = sigmoidf_(v0[j]); v1[j] = sigmoidf_(v1[j]); } }
                        u32x4 w; w.x = pk2(v0.x, v0.y); w.y = pk2(v0.z, v0.w); w.z = pk2(v1.x, v1.y); w.w = pk2(v1.z, v1.w);
                        bf16_t* dst = pn < 12 ? V + (size_t)r * 1024 + (c - 2048) : (pn < 16 ? SIGO + (size_t)r * 1024 + (c - 3072) : GATES + (size_t)r * 4096 + (c - 4096));
                        *(u32x4*)dst = w; }
                    else if (bj == 0 && cl == 0) { *(f32x4*)(ZIF + (size_t)r * 8) = v0; *(f32x4*)(ZIF + (size_t)r * 8 + 4) = v1; }
                }
            }
    }
};
struct EpiGlu {
    const bf16_t* YP; bf16_t* YO;
    DI void operator()(const AccT& acc, const pg8::Unit& u, int wr, int wc, int fr, int fq) const {
        const int row0 = u.pm * 256 + wr * 64 + fr, col0 = u.pn * 256 + wc * 32 + 8 * fq;
        u32x4 yv[8][2];
#pragma unroll
        for (int q = 0; q < 8; ++q)
#pragma unroll
            for (int bj = 0; bj < 2; ++bj) yv[q][bj] = *(const u32x4*)(YP + (size_t)(row0 + (q >> 2) * 128 + (q & 3) * 16) * 1024 + col0 + bj * 128);
#pragma unroll
        for (int ai = 0; ai < 2; ++ai)
#pragma unroll
            for (int m = 0; m < 4; ++m) {
                const int r = row0 + ai * 128 + m * 16;
#pragma unroll
                for (int bj = 0; bj < 2; ++bj) {
                    const size_t o = (size_t)r * 1024 + col0 + bj * 128;
                    const u32x4 y = yv[ai * 4 + m][bj]; const f32x4 a0 = acc[ai][bj][m][0], a1 = acc[ai][bj][m][1];
                    u32x4 w; w.x = pk2(bflo(y.x) * sigmoidf_(a0.x), bfhi(y.x) * sigmoidf_(a0.y)); w.y = pk2(bflo(y.y) * sigmoidf_(a0.z), bfhi(y.y) * sigmoidf_(a0.w));
                    w.z = pk2(bflo(y.z) * sigmoidf_(a1.x), bfhi(y.z) * sigmoidf_(a1.y)); w.w = pk2(bflo(y.w) * sigmoidf_(a1.z), bfhi(y.w) * sigmoidf_(a1.w));
                    *(u32x4*)(YO + o) = w; }
            }
    }
};
struct EpiBranch {
    const bf16_t* GATES; bf16_t* MG;
    DI void operator()(const AccT& acc, const pg8::Unit& u, int wr, int wc, int fr, int fq) const {
        const int row0 = u.pm * 256 + wr * 64 + fr, col0 = u.pn * 256 + wc * 32 + 8 * fq;
#pragma unroll
        for (int ai = 0; ai < 2; ++ai) {
            if ((u.mask >> (ai * 2)) & 3) {
            u32x4 gt[4][2], pv[4][2];
#pragma unroll
            for (int m = 0; m < 4; ++m)
#pragma unroll
                for (int bj = 0; bj < 2; ++bj) { const int r = row0 + ai * 128 + m * 16, c = col0 + bj * 128; gt[m][bj] = (u32x4){0u, 0u, 0u, 0u}; pv[m][bj] = gt[m][bj];
                    if ((u.mask >> (ai * 2 + bj)) & 1) { gt[m][bj] = *(const u32x4*)(GATES + (size_t)r * 4096 + u.sub * 2048 + c); if (u.sub) pv[m][bj] = *(const u32x4*)(MG + (size_t)r * D + c); } }
#pragma unroll
            for (int m = 0; m < 4; ++m) {
                const int r = row0 + ai * 128 + m * 16;
#pragma unroll
                for (int bj = 0; bj < 2; ++bj) {
                    if ((u.mask >> (ai * 2 + bj)) & 1) {
                    const int c = col0 + bj * 128;
                    const u32x4 g = gt[m][bj], p = pv[m][bj]; const f32x4 a0 = acc[ai][bj][m][0], a1 = acc[ai][bj][m][1];
                    float v[8] = {bflo(g.x) * a0.x, bfhi(g.x) * a0.y, bflo(g.y) * a0.z, bfhi(g.y) * a0.w, bflo(g.z) * a1.x, bfhi(g.z) * a1.y, bflo(g.w) * a1.z, bfhi(g.w) * a1.w};
                    if (u.sub) { v[0] += bflo(p.x); v[1] += bfhi(p.x); v[2] += bflo(p.y); v[3] += bfhi(p.y); v[4] += bflo(p.z); v[5] += bfhi(p.z); v[6] += bflo(p.w); v[7] += bfhi(p.w); }
                    u32x4 w; w.x = pk2(v[0], v[1]); w.y = pk2(v[2], v[3]); w.z = pk2(v[4], v[5]); w.w = pk2(v[6], v[7]);
                    *(u32x4*)(MG + (size_t)r * D + c) = w; } }
            } }
        }
    }
};

DI void tr_item(const float* W, int N, int srcn0, int nvalid, bf16_t* WT, int K, int dstrow0, int k0, LAS float* scr, int lane) {
    const int c4 = lane & 7, k8 = lane >> 3;
#pragma unroll
    for (int i = 0; i < 8; ++i) { const int kk = 8 * i + k8; f32x4 v = (f32x4){0.f, 0.f, 0.f, 0.f};
        if (4 * c4 < nvalid) v = __builtin_nontemporal_load((const f32x4*)(W + (size_t)(k0 + kk) * N + srcn0 + 4 * c4));
        LAS float* d = scr + kk * 33 + 4 * c4; d[0] = v.x; d[1] = v.y; d[2] = v.z; d[3] = v.w; }
    LDS_WAIT();
    const int c = lane & 7;
#pragma unroll
    for (int j = 0; j < 4; ++j) { const int n = (lane >> 3) + 8 * j; const LAS float* s = scr + (8 * c) * 33 + n;
        u32x4 o; o.x = pk2(s[0 * 33], s[1 * 33]); o.y = pk2(s[2 * 33], s[3 * 33]); o.z = pk2(s[4 * 33], s[5 * 33]); o.w = pk2(s[6 * 33], s[7 * 33]);
        *(u32x4*)(WT + (size_t)(dstrow0 + n) * K + k0 + 8 * c) = o; }
    LDS_WAIT();
}
constexpr int FFN_ITEMS_GU = 32 * 352, FFN_ITEMS_D = 88 * 64, FFN_ITEMS = FFN_ITEMS_GU + FFN_ITEMS_D;
DI void ffn_conv_item(const float* wg, const float* wu, const float* wd, bf16_t* dst, int it, LAS float* scr, int lane) {
    if (it < FFN_ITEMS_GU) { const int kb = it / 352, nb = it - kb * 352, d0 = nb * 32, tile = d0 >> 8, w = d0 & 255;
        tr_item(w < 128 ? wg : wu, DFF, tile * 128 + (w & 127), 32, dst, D, d0, kb * 64, scr, lane); }
    else { it -= FFN_ITEMS_GU; const int kb = it / 64, nb = it - kb * 64;
        tr_item(wd, D, nb * 32, 32, dst + (size_t)2 * DFF * D, DFF, nb * 32, kb * 64, scr, lane); }
}
DI void rms_row(Frame& F, int r, const float* gain, bf16_t* out) {
    const float* x = xrow(*F.P, r); u32x2* o = (u32x2*)(out + (size_t)r * D);
    if (!x) { for (int j = 0; j < 8; ++j) o[64 * j + F.lane] = (u32x2){0u, 0u}; return; }
    f32x4 v[8]; float s = 0.f;
#pragma unroll
    for (int j = 0; j < 8; ++j) { v[j] = ((const f32x4*)x)[64 * j + F.lane]; s += (v[j].x * v[j].x + v[j].y * v[j].y) + (v[j].z * v[j].z + v[j].w * v[j].w); }
    const float rs = rsqrtf(wave_sum(s) * (1.0f / D) + EPS);
#pragma unroll
    for (int j = 0; j < 8; ++j) { const f32x4 g = ((const f32x4*)gain)[64 * j + F.lane];
        o[64 * j + F.lane] = (u32x2){pk2(v[j].x * rs * g.x, v[j].y * rs * g.y), pk2(v[j].z * rs * g.z, v[j].w * rs * g.w)}; }
}
DI void s5_precompute(Frame& F, int g) {
    const Params& P = *F.P;
    LAS float* pw = (LAS float*)F.lds;
    LAS float* Bb = pw + 9 * 128;
    LAS float* Cc = Bb + 2048;
    LAS float* Kd = Cc + 2048;
    const int tid = F.tid;
    if (tid < 64) { const int p = tid;
        const float are = P.in[I_AR][g * 64 + p], aim = P.in[I_AI][g * 64 + p], dt = expf(P.in[I_LDT][g]);
        const float er = expf(are * dt), ang = aim * dt; const float ar = er * cosf(ang), ai = er * sinf(ang);
        float pr = 1.f, pi = 0.f;
        for (int d = 0; d <= 8; ++d) { pw[(d * 64 + p) * 2] = pr; pw[(d * 64 + p) * 2 + 1] = pi; const float nr = pr * ar - pi * ai, ni = pr * ai + pi * ar; pr = nr; pi = ni; }
        float* a8 = (float*)(F.ws + WS_A8) + (g * 64 + p) * 2; a8[0] = pw[(8 * 64 + p) * 2]; a8[1] = pw[(8 * 64 + p) * 2 + 1];
        const float nr = ar - 1.f, ni = ai, den = 1.0f / (are * are + aim * aim);
        const float cr = (nr * are + ni * aim) * den, ci = (ni * are - nr * aim) * den;
        for (int h = 0; h < 16; ++h) { const float br = P.in[I_BR][(g * 64 + p) * 16 + h], bi = P.in[I_BI][(g * 64 + p) * 16 + h];
            Bb[(p * 16 + h) * 2] = cr * br - ci * bi; Bb[(p * 16 + h) * 2 + 1] = cr * bi + ci * br; }
    }
    for (int e = tid; e < 1024; e += 512) { Cc[e * 2] = P.in[I_CR][g * 1024 + e]; Cc[e * 2 + 1] = P.in[I_CI][g * 1024 + e]; }
    __syncthreads();
    bf16_t* Em = (bf16_t*)(F.ws + WS_S5M) + (size_t)g * 3 * 16384; bf16_t* Mm = Em + 16384; bf16_t* Fm = Em + 32768;
    for (int e = tid; e < 2048; e += 512) { const int d = e >> 8, h = (e >> 4) & 15, h2 = e & 15; float s = 0.f;
        for (int p = 0; p < 64; ++p) { const float cr = Cc[(h * 64 + p) * 2], ci = Cc[(h * 64 + p) * 2 + 1], wr_ = pw[(d * 64 + p) * 2], wi = pw[(d * 64 + p) * 2 + 1];
            const float xr = cr * wr_ - ci * wi, xi = cr * wi + ci * wr_; s += xr * Bb[(p * 16 + h2) * 2] - xi * Bb[(p * 16 + h2) * 2 + 1]; }
        Kd[e] = s; }
    for (int e = tid; e < 16384; e += 512) { const int n = e >> 7, k = e & 127;
        { const int ri = n >> 6, p = n & 63, s = k >> 4, h2 = k & 15; const float wr_ = pw[((7 - s) * 64 + p) * 2], wi = pw[((7 - s) * 64 + p) * 2 + 1], br = Bb[(p * 16 + h2) * 2], bi = Bb[(p * 16 + h2) * 2 + 1];
          Em[e] = f2bf(ri ? wr_ * bi + wi * br : wr_ * br - wi * bi); }
        { const int t = n >> 4, h = n & 15, ri = k >> 6, p = k & 63; const float cr = Cc[(h * 64 + p) * 2], ci = Cc[(h * 64 + p) * 2 + 1], wr_ = pw[((t + 1) * 64 + p) * 2], wi = pw[((t + 1) * 64 + p) * 2 + 1];
          Fm[e] = f2bf(ri ? -(cr * wi + ci * wr_) : cr * wr_ - ci * wi); }
    }
    __syncthreads();
    for (int e = tid; e < 16384; e += 512) { const int n = e >> 7, k = e & 127, t = n >> 4, h = n & 15, s = k >> 4, h2 = k & 15;
        Mm[e] = f2bf(s <= t ? Kd[((t - s) * 16 + h) * 16 + h2] : 0.f); }
    __syncthreads();
}

DI int hsw(int r, int c) { return r * 128 + (c ^ ((r & 15) << 3)); }
constexpr int S5_UROW = 136;
DI void s5_item(Frame& F, int item) {
    const Params& P = *F.P;
    const bool samp = item >= 256; const int g = samp ? item - 256 : (item & 63), n = samp ? 0 : (item >> 6);
    const int npass = samp ? 1 : 2, prow = samp ? 128 : 129, nunits = samp ? 16 : 20, tokbase = samp ? PROWS : n * LP;
    LAS float* H = (LAS float*)F.lds;
    LAS bf16_t* U = (LAS bf16_t*)(F.lds + 160 * 512);
    const bf16_t* Em = (const bf16_t*)(F.ws + WS_S5M) + (size_t)g * 3 * 16384; const bf16_t* Mm = Em + 16384; const bf16_t* Fm = Em + 32768;
    const float* US5 = (const float*)(F.ws + WS_US5); bf16_t* YP = (bf16_t*)(F.ws + WS_YS5P);
    const int lane = F.lane, r31 = lane & 31, hh = lane >> 5;
    const float* a8p = (const float*)(F.ws + WS_A8) + (g * 64 + lane) * 2; const float ar = a8p[0], ai = a8p[1];
    float hr = 0.f, hi = 0.f;
#pragma unroll 1
    for (int pass = 0; pass < npass; ++pass) {
        const int tok0 = tokbase + pass * prow * 8;
        for (int e = F.tid; e < prow * 8 * 4; e += 512) { const int tk = e >> 2, q = e & 3; const f32x4 v = *(const f32x4*)(US5 + (size_t)(tok0 + tk) * 1024 + g * 16 + q * 4);
            *(LAS u32x2*)(U + (tk >> 3) * S5_UROW + (tk & 7) * 16 + q * 4) = (u32x2){pk2(v.x, v.y), pk2(v.z, v.w)}; }
        __syncthreads();
#pragma unroll 1
        for (int u = F.wave; u < nunits; u += 8) {
            const int rb = u >> 2, nb = u & 3, row = rb * 32 + r31; const bool valid = row < prow;
            bf16x8 bfr[8];
#pragma unroll
            for (int kb = 0; kb < 8; ++kb) bfr[kb] = *(const bf16x8*)(Em + (nb * 32 + r31) * 128 + kb * 16 + 8 * hh);
            f32x16 acc = zero16();
#pragma unroll
            for (int kb = 0; kb < 8; ++kb) { bf16x8 a = (bf16x8){0, 0, 0, 0, 0, 0, 0, 0}; if (valid) a = *(const LAS bf16x8*)(U + row * S5_UROW + kb * 16 + 8 * hh); acc = MFMA32(a, bfr[kb], acc); }
#pragma unroll
            for (int reg = 0; reg < 16; ++reg) H[hsw(rb * 32 + crow(reg, hh), nb * 32 + r31)] = acc[reg];
        }
        __syncthreads();
        if (samp) { for (int r = F.wave; r < 128; r += 8) { const size_t si = ((size_t)r * 64 + g) * 64 + lane; const float h0r = P.in[I_S5RE][si], h0i = P.in[I_S5IM][si];
                const float lr = H[hsw(r, lane)], li = H[hsw(r, 64 + lane)];
                P.out[O_SS5R + si] = ar * h0r - ai * h0i + lr; P.out[O_SS5I + si] = ar * h0i + ai * h0r + li; H[hsw(r, lane)] = h0r; H[hsw(r, 64 + lane)] = h0i; } }
        else if (F.wave == 0) {
#pragma unroll 1
            for (int j0 = 0; j0 < 136; j0 += 8) { float lr[8], li[8];
#pragma unroll
                for (int q = 0; q < 8; ++q) { const int j = j0 + q < 129 ? j0 + q : 128; lr[q] = H[hsw(j, lane)]; li[q] = H[hsw(j, 64 + lane)]; }
#pragma unroll
                for (int q = 0; q < 8; ++q) { if (j0 + q < 129) { H[hsw(j0 + q, lane)] = hr; H[hsw(j0 + q, 64 + lane)] = hi;
                    const float nr = ar * hr - ai * hi + lr[q], ni = ar * hi + ai * hr + li[q]; hr = nr; hi = ni; } } }
            if (pass == 1) { const size_t si = ((size_t)n * 64 + g) * 64 + lane; P.out[O_PS5R + si] = hr; P.out[O_PS5I + si] = hi; } }
        __syncthreads();
#pragma unroll 1
        for (int u = F.wave; u < nunits; u += 8) {
            const int rb = u >> 2, nb = u & 3, row = rb * 32 + r31; const bool valid = row < prow;
            const int col = nb * 32 + r31, t = col >> 4, ch = g * 16 + (col & 15); const float Dv = P.in[I_S5D][ch];
            bf16x8 mfr[8], ffr[8]; float uo[16];
#pragma unroll
            for (int kb = 0; kb < 8; ++kb) { mfr[kb] = *(const bf16x8*)(Mm + (nb * 32 + r31) * 128 + kb * 16 + 8 * hh); ffr[kb] = *(const bf16x8*)(Fm + (nb * 32 + r31) * 128 + kb * 16 + 8 * hh); }
#pragma unroll
            for (int reg = 0; reg < 16; ++reg) { const int rr = rb * 32 + crow(reg, hh); uo[reg] = rr < prow ? US5[(size_t)(tok0 + rr * 8 + t) * 1024 + ch] : 0.f; }
            f32x16 acc = zero16();
#pragma unroll
            for (int kb = 0; kb < 8; ++kb) { bf16x8 a = (bf16x8){0, 0, 0, 0, 0, 0, 0, 0}; if (valid) a = *(const LAS bf16x8*)(U + row * S5_UROW + kb * 16 + 8 * hh); acc = MFMA32(a, mfr[kb], acc); }
#pragma unroll
            for (int kb = 0; kb < 8; ++kb) { const LAS float* hp = H + row * 128 + (((kb * 2 + hh) ^ (row & 15)) << 3); acc = MFMA32(cvt_frag(*(const LAS f32x4*)hp, *(const LAS f32x4*)(hp + 4)), ffr[kb], acc); }
#pragma unroll
            for (int reg = 0; reg < 16; ++reg) { const int rr = rb * 32 + crow(reg, hh);
                if (rr < prow) YP[(size_t)(tok0 + rr * 8 + t) * 1024 + ch] = f2bf(gelu_tanh(acc[reg] + Dv * uo[reg])); }
        }
        __syncthreads();
    }
}

constexpr int VT_STRIDE = 72;
DI float log_sigmoid(float x) { return fminf(x, 0.f) - log1pf(expf(-fabsf(x))); }
DI float conv1(const Params& P, float xm3, float xm2, float xm1, float x0, int col) {
    const float* w = P.in[I_CW]; return siluf_(xm3 * w[col] + xm2 * w[1024 + col] + xm1 * w[2048 + col] + x0 * w[3072 + col] + P.in[I_CB][col]);
}
DI void mlstm_prep(Frame& F, int item) {
    const Params& P = *F.P;
    const int hd = item & 3, c = (item >> 2) % NCH, n = (item >> 2) / NCH;
    const int t0 = c == 0 ? 0 : 16 + 64 * (c - 1), L = c == 0 ? 16 : 64, R0 = n * LP + t0;
    LAS bf16_t* KT = (LAS bf16_t*)F.lds;
    LAS bf16_t* VT = KT + 128 * VT_STRIDE + F.wave * 32 * VT_STRIDE;
    LAS float* wsc = (LAS float*)(F.lds + (128 + 256) * VT_STRIDE * 2);
    const float* ZIF = (const float*)(F.ws + WS_ZIF); const float* QKPRE = (const float*)(F.ws + WS_QKPRE);
    bf16_t* QK = (bf16_t*)(F.ws + WS_QK); const bf16_t* V = (const bf16_t*)(F.ws + WS_HID) + (size_t)MR * 4096;
    const int lane = F.lane, tid = F.tid;
    if (F.wave == 0) { const bool valid = lane < L; const int R = R0 + lane;
        const float ig = valid ? ZIF[(size_t)R * 8 + hd] + P.in[I_MBI][hd] : 0.f;
        const float lf = valid ? log_sigmoid(ZIF[(size_t)R * 8 + 4 + hd] + P.in[I_MBF][hd]) : 0.f;
        float b = lf; for (int o = 1; o < 64; o <<= 1) { const float t = __shfl_up(b, o); if (lane >= o) b += t; }
        const float bL = __shfl(b, L - 1);
        const float a = valid ? bL - b + ig : -INFINITY; const float mloc = wave_max(a);
        wsc[lane] = valid ? __expf(a - mloc) : 0.f;
        if (valid) { ((float*)(F.ws + WS_GB))[(size_t)R * 4 + hd] = b; ((float*)(F.ws + WS_GI))[(size_t)R * 4 + hd] = ig; }
        if (lane == 0) { float* its = (float*)(F.ws + WS_ITS); its[item] = bL; its[NITEM + item] = mloc; }
    }
    __syncthreads();
    { const int ch = tid & 255, col = ch < 128 ? hd * 128 + ch : 512 + hd * 128 + (ch - 128), s0 = (tid >> 8) * 32;
      const float* cw = P.in[I_CW]; const float w0 = cw[col], w1 = cw[1024 + col], w2 = cw[2048 + col], w3 = cw[3072 + col], cb = P.in[I_CB][col];
#pragma unroll 1
      for (int sq = s0; sq < s0 + 32 && sq < L; sq += 16) {
          const float* xp = QKPRE + (size_t)(R0 + sq) * 1024 + col; bf16_t* qo = QK + (size_t)(R0 + sq) * 1024 + col;
          float x[19];
#pragma unroll
          for (int i = 0; i < 19; ++i) x[i] = (t0 + sq - 3 + i >= 0) ? xp[(i - 3) * 1024] : 0.f;
#pragma unroll
          for (int i = 0; i < 16; ++i) {
              float v = siluf_(x[i] * w0 + x[i + 1] * w1 + x[i + 2] * w2 + x[i + 3] * w3 + cb); if (ch < 128) v *= 0.08838834764831845f;
              qo[i * 1024] = f2bf(v);
              if (ch >= 128) KT[(ch - 128) * VT_STRIDE + sq + i] = f2bf(v * wsc[sq + i]); } } }
    { const bool valid = lane < L; const bf16_t* vp = V + (size_t)(R0 + lane) * 1024 + hd * 256 + F.wave * 32;
#pragma unroll
      for (int q = 0; q < 4; ++q) { u32x4 w = (u32x4){0u, 0u, 0u, 0u}; if (valid) w = *(const u32x4*)(vp + q * 8);
          const unsigned ww[4] = {w.x, w.y, w.z, w.w};
#pragma unroll
          for (int j = 0; j < 4; ++j) { VT[(q * 8 + 2 * j) * VT_STRIDE + lane] = (bf16_t)(ww[j] & 0xffffu); VT[(q * 8 + 2 * j + 1) * VT_STRIDE + lane] = (bf16_t)(ww[j] >> 16); } } }
    __syncthreads();
    { const int r31 = lane & 31, hh = lane >> 5, nks = c == 0 ? 1 : 4;
      float* DC = (float*)(F.ws + WS_WFF) + (size_t)item * 32768;
#pragma unroll 1
      for (int nb = 0; nb < 4; ++nb) { f32x16 acc = zero16();
          for (int ks = 0; ks < nks; ++ks) { const bf16x8 a = *(const LAS bf16x8*)(VT + r31 * VT_STRIDE + ks * 16 + 8 * hh), b = *(const LAS bf16x8*)(KT + (nb * 32 + r31) * VT_STRIDE + ks * 16 + 8 * hh); acc = MFMA32(a, b, acc); }
#pragma unroll
          for (int reg = 0; reg < 16; ++reg) DC[(F.wave * 32 + crow(reg, hh)) * 128 + nb * 32 + r31] = acc[reg]; }
      if (tid < 128) { float s = 0.f; for (int q = 0; q < L; ++q) s += bf1(KT[tid * VT_STRIDE + q]); ((float*)(F.ws + WS_DN))[item * 128 + tid] = s; } }
    __syncthreads();
}
DI void mlstm_scan(Frame& F) {
    const Params& P = *F.P;
    const float* its = (const float*)(F.ws + WS_ITS); float* m0s = (float*)(F.ws + WS_ITS) + 2 * NITEM;
    const float* DC = (const float*)(F.ws + WS_WFF); bf16_t* CJ = (bf16_t*)(F.ws + WS_XA);
    const int gid = F.bid * 512 + F.tid;
    if (gid < 16 * 8192) { const int chain = gid >> 13, e4 = gid & 8191, n = chain >> 2, hd = chain & 3;
        f32x4 C = (f32x4){0.f, 0.f, 0.f, 0.f}; float m0 = 0.f;
#pragma unroll 1
        for (int c0 = 0; c0 < NCH; c0 += 11) { f32x4 d[11];
#pragma unroll
            for (int j = 0; j < 11; ++j) d[j] = __builtin_nontemporal_load((const f32x4*)(DC + (size_t)((n * NCH + c0 + j) * 4 + hd) * 32768 + e4 * 4));
#pragma unroll
            for (int j = 0; j < 11; ++j) { const int item = (n * NCH + c0 + j) * 4 + hd;
                const float bL = its[item], ml = its[NITEM + item], mn = fmaxf(bL + m0, ml), dec = __expf(bL + m0 - mn), sc = __expf(ml - mn);
                *(u32x2*)(CJ + (size_t)item * 32768 + e4 * 4) = (u32x2){pk2(C.x, C.y), pk2(C.z, C.w)};
                C = C * dec + d[j] * sc; m0 = mn; } }
        *(f32x4*)(P.out + O_PC + (size_t)chain * 32768 + e4 * 4) = C; }
    if (F.bid == 255) { const int chain = F.tid >> 5, k4 = F.tid & 31, n = chain >> 2, hd = chain & 3;
        const float* DN = (const float*)(F.ws + WS_DN); float* NJ = (float*)(F.ws + WS_NJ);
        f32x4 C = (f32x4){0.f, 0.f, 0.f, 0.f}; float m0 = 0.f;
        for (int c = 0; c < NCH; ++c) { const int item = (n * NCH + c) * 4 + hd;
            const float bL = its[item], ml = its[NITEM + item], mn = fmaxf(bL + m0, ml), dec = __expf(bL + m0 - mn), sc = __expf(ml - mn);
            *(f32x4*)(NJ + item * 128 + k4 * 4) = C; if (k4 == 0) m0s[item] = m0;
            const f32x4 d = *(const f32x4*)(DN + item * 128 + k4 * 4);
            C = C * dec + d * sc; m0 = mn; }
        *(f32x4*)(P.out + O_PN + chain * 128 + k4 * 4) = C; if (k4 == 0) P.out[O_PM + chain] = m0; }
}
DI void out_xtile(const bf16x8 (&kf)[8], const bf16x8 (&qf)[8], int sb, int t, int L, float bmt, const LAS float* sm, const LAS bf16_t* VT, int r31, int hh, f32x16& acc1, float& den1) {
    f32x16 x = zero16();
#pragma unroll
    for (int ks = 0; ks < 8; ++ks) x = MFMA32(kf[ks], qf[ks], x);
#pragma unroll
    for (int reg = 0; reg < 16; ++reg) { const int s = sb * 32 + crow(reg, hh); const float w = (s <= t && s < L) ? __expf(sm[s] + bmt) : 0.f; x[reg] *= w; den1 += x[reg]; }
#pragma unroll
    for (int st = 0; st < 2; ++st) { u32x4 p; p.x = pk2(x[8 * st], x[8 * st + 1]); p.y = pk2(x[8 * st + 2], x[8 * st + 3]); p.z = pk2(x[8 * st + 4], x[8 * st + 5]); p.w = pk2(x[8 * st + 6], x[8 * st + 7]);
        const LAS bf16_t* vv = VT + r31 * VT_STRIDE + sb * 32 + 16 * st + 4 * hh; const u32x2 v0 = *(const LAS u32x2*)vv, v1 = *(const LAS u32x2*)(vv + 8);
        const u32x4 vb = (u32x4){v0.x, v0.y, v1.x, v1.y};
        acc1 = MFMA32(__builtin_bit_cast(bf16x8, p), __builtin_bit_cast(bf16x8, vb), acc1); }
}
constexpr int QS_ROW = 136;
DI void mlstm_out(Frame& F, int item) {
    const int hd = item & 3, c = (item >> 2) % NCH, n = (item >> 2) / NCH;
    const int t0 = c == 0 ? 0 : 16 + 64 * (c - 1), L = c == 0 ? 16 : 64, R0 = n * LP + t0, ntb = c == 0 ? 1 : 2;
    LAS bf16_t* Qs = (LAS bf16_t*)F.lds; LAS bf16_t* Ks = Qs + 64 * QS_ROW;
    LAS bf16_t* VT = Ks + 64 * QS_ROW + F.wave * 32 * VT_STRIDE;
    LAS float* sm = (LAS float*)(F.lds + (2 * 64 * QS_ROW + 256 * VT_STRIDE) * 2) + F.wave * 512;
    const bf16_t* QK = (const bf16_t*)(F.ws + WS_QK); const bf16_t* V = (const bf16_t*)(F.ws + WS_HID) + (size_t)MR * 4096;
    const bf16_t* CJ = (const bf16_t*)(F.ws + WS_XA) + (size_t)item * 32768; const float* NJ = (const float*)(F.ws + WS_NJ) + item * 128;
    float* HU = (float*)(F.ws + WS_US5);
    const int lane = F.lane, r31 = lane & 31, hh = lane >> 5, tid = F.tid;
    const bool valid = lane < L;
    const float m0 = ((const float*)(F.ws + WS_ITS))[2 * NITEM + item];
    bf16x8 cf[8];
#pragma unroll
    for (int ks = 0; ks < 8; ++ks) cf[ks] = *(const bf16x8*)(CJ + (F.wave * 32 + r31) * 128 + ks * 16 + 8 * hh);
#pragma unroll
    for (int i = 0; i < 2; ++i) { const int e = tid + i * 512, row = e >> 4, c16 = e & 15; const bf16_t* src = QK + (size_t)(R0 + row) * 1024 + hd * 128 + c16 * 8;
        const u32x4 q = *(const u32x4*)src, k = *(const u32x4*)(src + 512);
        *(LAS u32x4*)(Qs + row * QS_ROW + c16 * 8) = q; *(LAS u32x4*)(Ks + row * QS_ROW + c16 * 8) = k; }
    { const float b = valid ? ((const float*)(F.ws + WS_GB))[(size_t)(R0 + lane) * 4 + hd] : 0.f, ig = valid ? ((const float*)(F.ws + WS_GI))[(size_t)(R0 + lane) * 4 + hd] : 0.f;
      const float cs = valid ? ig - b : -INFINITY; float pm = cs;
      for (int o = 1; o < 64; o <<= 1) { const float t = __shfl_up(pm, o); if (lane >= o) pm = fmaxf(pm, t); }
      const float bm = -fmaxf(m0, pm);
      sm[lane] = cs; sm[64 + lane] = bm; sm[128 + lane] = __expf(m0 + bm); sm[448 + lane] = __expf(bm - b); sm[256 + lane] = NJ[lane]; sm[320 + lane] = NJ[64 + lane]; }
#pragma unroll
    for (int i = 0; i < 4; ++i) { const int s = 16 * i + (lane >> 2), v8 = (lane & 3) * 8; u32x4 w = (u32x4){0u, 0u, 0u, 0u};
        if (s < L) w = *(const u32x4*)(V + (size_t)(R0 + s) * 1024 + hd * 256 + F.wave * 32 + v8);
        const unsigned ww[4] = {w.x, w.y, w.z, w.w};
#pragma unroll
        for (int j = 0; j < 4; ++j) { VT[(v8 + 2 * j) * VT_STRIDE + s] = (bf16_t)(ww[j] & 0xffffu); VT[(v8 + 2 * j + 1) * VT_STRIDE + s] = (bf16_t)(ww[j] >> 16); } }
    __syncthreads();
#pragma unroll
    for (int tb = 0; tb < 2; ++tb) { if (tb < ntb) {
        const int t = tb * 32 + r31; const float bmt = sm[64 + t];
        bf16x8 qf[8];
#pragma unroll
        for (int ks = 0; ks < 8; ++ks) qf[ks] = *(const LAS bf16x8*)(Qs + t * QS_ROW + ks * 16 + 8 * hh);
        float den2 = 0.f;
#pragma unroll
        for (int ks = 0; ks < 8; ++ks) { const u32x4 w = __builtin_bit_cast(u32x4, qf[ks]); const LAS float* nn = sm + 256 + ks * 16 + 8 * hh;
            den2 += bflo(w.x) * nn[0] + bfhi(w.x) * nn[1] + bflo(w.y) * nn[2] + bfhi(w.y) * nn[3] + bflo(w.z) * nn[4] + bfhi(w.z) * nn[5] + bflo(w.w) * nn[6] + bfhi(w.w) * nn[7]; }
        den2 += __shfl_xor(den2, 32);
        f32x16 acc1 = zero16(), acc2 = zero16(); float den1 = 0.f;
#pragma unroll
        for (int sb = 0; sb < 2; ++sb) { if (sb <= tb) {
            bf16x8 kf[8];
#pragma unroll
            for (int ks = 0; ks < 8; ++ks) kf[ks] = *(const LAS bf16x8*)(Ks + (sb * 32 + r31) * QS_ROW + ks * 16 + 8 * hh);
            out_xtile(kf, qf, sb, t, L, bmt, sm, VT, r31, hh, acc1, den1); } }
#pragma unroll
        for (int ks = 0; ks < 8; ++ks) acc2 = MFMA32(qf[ks], cf[ks], acc2);
        den1 += __shfl_xor(den1, 32);
        { const float den = den1 + sm[128 + t] * den2; if (hh == 0) sm[192 + t] = 1.0f / fmaxf(fabsf(den), sm[448 + t]); }
        LDS_WAIT();
#pragma unroll
        for (int reg = 0; reg < 16; ++reg) { const int tt = tb * 32 + crow(reg, hh);
            if (tt < L) HU[(size_t)(R0 + tt) * 1024 + hd * 256 + F.wave * 32 + r31] = (acc1[reg] + sm[128 + tt] * acc2[reg]) * sm[192 + tt]; }
    } }
    __syncthreads();
}
DI void mlstm_sample(Frame& F, int chain) {
    const Params& P = *F.P;
    const int n = chain >> 2, hd = chain & 3, R0 = PROWS + n * 8;
    LAS float* qs = (LAS float*)F.lds;
    LAS float* ks = qs + 1024;
    LAS float* vs = ks + 1024;
    LAS float* ss = vs + 2048;
    LAS float* ga = ss + 64;
    const float* ZIF = (const float*)(F.ws + WS_ZIF); const float* QKPRE = (const float*)(F.ws + WS_QKPRE);
    const bf16_t* V = (const bf16_t*)(F.ws + WS_HID) + (size_t)MR * 4096; float* HU = (float*)(F.ws + WS_US5);
    const int tid = F.tid, lane = F.lane;
    const float m0 = P.in[I_MM][chain];
    if (F.wave == 0) { const bool valid = lane < 8; const int R = R0 + lane;
        const float ig = valid ? ZIF[(size_t)R * 8 + hd] + P.in[I_MBI][hd] : 0.f;
        const float lf = valid ? log_sigmoid(ZIF[(size_t)R * 8 + 4 + hd] + P.in[I_MBF][hd]) : 0.f;
        float b = lf; for (int o = 1; o < 64; o <<= 1) { const float t = __shfl_up(b, o); if (lane >= o) b += t; }
        const float cs = valid ? ig - b : -INFINITY; float pm = cs;
        for (int o = 1; o < 64; o <<= 1) { const float t = __shfl_up(pm, o); if (lane >= o) pm = fmaxf(pm, t); }
        const float bm = -fmaxf(m0, pm), mt = b - bm;
        const float bL = __shfl(b, 7), mnew = __shfl(mt, 7);
        if (valid) { ga[lane] = __expf(bL - b + ig - mnew); ga[8 + lane] = cs; ga[16 + lane] = bm; ga[24 + lane] = __expf(m0 + bm); ga[32 + lane] = __expf(-mt); }
        if (lane == 0) { ga[56] = __expf(bL + m0 - mnew); P.out[O_SM + chain] = mnew; }
    }
    for (int e = tid; e < 2048; e += 512) { const int s = e >> 8, ch = e & 255, col = ch < 128 ? hd * 128 + ch : 512 + hd * 128 + (ch - 128);
        float x[4];
#pragma unroll
        for (int j = 0; j < 4; ++j) { const int t = s - 3 + j; x[j] = t >= 0 ? QKPRE[(size_t)(R0 + t) * 1024 + col] : P.in[I_MCONV][((size_t)n * 3 + (3 + t)) * 1024 + col]; }
        const float v = conv1(P, x[0], x[1], x[2], x[3], col);
        if (ch < 128) qs[s * 128 + ch] = v * 0.08838834764831845f; else ks[s * 128 + ch - 128] = v; }
    for (int e = tid; e < 2048; e += 512) { const int s = e >> 8, v = e & 255; vs[e] = bf1(V[(size_t)(R0 + s) * 1024 + hd * 256 + v]); }
    __syncthreads();
    if (F.wave == 0) { const int t = lane >> 3, s = lane & 7; float d = 0.f;
        if (s <= t) { for (int k = 0; k < 128; ++k) d += qs[t * 128 + k] * ks[s * 128 + k]; d *= __expf(ga[8 + s] + ga[16 + t]); }
        ss[lane] = d; }
    else if (F.wave == 1) { const int t = lane >> 3, part = lane & 7; float d = 0.f;
        for (int k = part * 16; k < part * 16 + 16; ++k) d += P.in[I_MN][chain * 128 + k] * qs[t * 128 + k];
        d += __shfl_xor(d, 1); d += __shfl_xor(d, 2); d += __shfl_xor(d, 4); if (part == 0) ga[40 + t] = d; }
    __syncthreads();
    if (tid < 8) { float den = 0.f; for (int s = 0; s < 8; ++s) den += ss[tid * 8 + s]; den += ga[24 + tid] * ga[40 + tid]; ga[48 + tid] = 1.0f / fmaxf(fabsf(den), ga[32 + tid]); }
    __syncthreads();
    { const float decay = ga[56];
      const float* C0 = P.in[I_MC] + (size_t)chain * 32768; float* Cn = P.out + O_SC + (size_t)chain * 32768;
      { const int r31 = lane & 31, hh = lane >> 5; f32x16 acc = zero16();
        f32x4 ca[8], cb[8];
#pragma unroll
        for (int kq = 0; kq < 8; ++kq) { const float* cp = C0 + (F.wave * 32 + r31) * 128 + kq * 16 + 8 * hh; ca[kq] = *(const f32x4*)cp; cb[kq] = *(const f32x4*)(cp + 4); }
#pragma unroll
        for (int kq = 0; kq < 8; ++kq) { f32x4 qa = (f32x4){0.f, 0.f, 0.f, 0.f}, qb = qa;
            if (r31 < 8) { const LAS float* qp = qs + r31 * 128 + kq * 16 + 8 * hh; qa = *(const LAS f32x4*)qp; qb = *(const LAS f32x4*)(qp + 4); }
            acc = MFMA32(cvt_frag(ca[kq], cb[kq]), cvt_frag(qa, qb), acc); }
        if (r31 < 8) { const int t = r31; const float it = ga[24 + t], iv = ga[48 + t];
#pragma unroll
            for (int reg = 0; reg < 16; ++reg) { const int v = F.wave * 32 + crow(reg, hh); float sv = 0.f;
#pragma unroll
                for (int s = 0; s < 8; ++s) sv += ss[t * 8 + s] * vs[s * 256 + v];
                HU[(size_t)(R0 + t) * 1024 + hd * 256 + v] = (sv + it * acc[reg]) * iv; } } }
      { const int k4 = tid & 31, vr = tid >> 5;
        f32x4 kr[8];
#pragma unroll
        for (int t = 0; t < 8; ++t) kr[t] = *(const LAS f32x4*)(ks + t * 128 + k4 * 4);
#pragma unroll 1
        for (int p0 = 0; p0 < 16; p0 += 4) { f32x4 c0s[4];
#pragma unroll
            for (int q = 0; q < 4; ++q) c0s[q] = __builtin_nontemporal_load((const f32x4*)(C0 + ((p0 + q) * 16 + vr) * 128 + k4 * 4));
#pragma unroll
            for (int q = 0; q < 4; ++q) { const int v = (p0 + q) * 16 + vr; f32x4 cn = c0s[q] * decay;
#pragma unroll
                for (int s = 0; s < 8; ++s) cn += kr[s] * (ga[s] * vs[s * 256 + v]);
                __builtin_nontemporal_store(cn, (f32x4*)(Cn + v * 128 + k4 * 4)); } } }
      if (tid < 128) { float nn = decay * P.in[I_MN][chain * 128 + tid]; for (int s = 0; s < 8; ++s) nn += ga[s] * ks[s * 128 + tid]; P.out[O_SN + chain * 128 + tid] = nn; } }
    __syncthreads();
}
DI void yml_row(Frame& F, int r) {
    const float* HU = (const float*)(F.ws + WS_US5) + (size_t)r * 1024; const bf16_t* SG = (const bf16_t*)(F.ws + WS_SIGO) + (size_t)r * 1024;
    u32x2* o = (u32x2*)((bf16_t*)(F.ws + WS_QKPRE) + (size_t)r * 1024);
    if (r >= NTOK) { for (int j = 0; j < 4; ++j) o[64 * j + F.lane] = (u32x2){0u, 0u}; return; }
#pragma unroll
    for (int j = 0; j < 4; ++j) { const f32x4 v = ((const f32x4*)HU)[64 * j + F.lane]; const float s = wave_sum((v.x * v.x + v.y * v.y) + (v.z * v.z + v.w * v.w));
        const float rn = rsqrtf(s * (1.0f / 256.0f) + EPS); const f32x4 g = ((const f32x4*)F.P->in[I_MNORM])[64 * j + F.lane]; const u32x2 sg = ((const u32x2*)SG)[64 * j + F.lane];
        o[64 * j + F.lane] = (u32x2){pk2(v.x * rn * g.x * bflo(sg.x), v.y * rn * g.y * bfhi(sg.x)), pk2(v.z * rn * g.z * bflo(sg.y), v.w * rn * g.w * bfhi(sg.y))}; }
}


DI int grab_item(Frame& F, unsigned* cnt) {
    volatile LAS int* slot = (volatile LAS int*)(F.lds + 288 * 512 + 768);
    if (F.tid == 0) *slot = (int)__hip_atomic_fetch_add(cnt, 1u, __ATOMIC_RELAXED, __HIP_MEMORY_SCOPE_AGENT);
    __syncthreads();
    const int v = *slot;
    __syncthreads();
    return v;
}

#define XB_TMO      128
#define XB_XCNT(j)  (256  + 64 * (j))
#define XB_XSUB(j)  (1280 + 64 * (j))
#define XB_XGEN(j)  (2304 + 64 * (j))
#define XB_TOP      3328
#define XB_TOPGEN   3392
#define XCD_BAR_WORDS 3456
#define XB_SPIN_CAP (1u << 22)
DI unsigned xb_ld(unsigned* p)              { return __hip_atomic_load(p, __ATOMIC_RELAXED, __HIP_MEMORY_SCOPE_AGENT); }
DI unsigned xb_add(unsigned* p, unsigned v) { return __hip_atomic_fetch_add(p, v, __ATOMIC_RELAXED, __HIP_MEMORY_SCOPE_AGENT); }
DI unsigned xb_xcc_id() { return (unsigned)__builtin_amdgcn_s_getreg((3 << 11) | 20) & 0xFu; }
#define XB_SPIN(cond, bar) do { unsigned _sp = 0; while (cond) { __builtin_amdgcn_s_sleep(1); \
    if ((++_sp & 255u) == 0u) { if (xb_ld(&(bar)[XB_TMO])) break; if (_sp > XB_SPIN_CAP) { atomicAdd(&(bar)[XB_TMO], 1u); break; } } } } while (0)
struct XcdBarrier { unsigned* bar; unsigned x; volatile LAS unsigned* st; };
DI XcdBarrier xcd_barrier_post(unsigned* bar, volatile LAS unsigned* st) {
    XcdBarrier b; b.bar = bar; b.x = xb_xcc_id(); b.st = st;
    if (threadIdx.x == 0) (void)xb_add(&bar[XB_XCNT(b.x)], 1u);
    return b;
}
DI void xcd_barrier_complete(unsigned* bar, unsigned x, unsigned& nloc, unsigned& nx) {
    const unsigned G = gridDim.x * gridDim.y * gridDim.z;
    unsigned sum, cnt, mine, sp = 0u;
    for (;;) {
        sum = 0u; cnt = 0u; mine = 0u;
#pragma unroll
        for (unsigned j = 0; j < 16; ++j) { const unsigned c = xb_ld(&bar[XB_XCNT(j)]); sum += c; cnt += (c > 0u) ? 1u : 0u; mine = (j == x) ? c : mine; }
        if (sum == G) break;
        __builtin_amdgcn_s_sleep(1);
        if ((++sp & 255u) == 0u) { if (xb_ld(&bar[XB_TMO])) break; if (sp > XB_SPIN_CAP) { atomicAdd(&bar[XB_TMO], 1u); break; } }
    }
    nloc = mine > 0u ? mine : 1u; nx = cnt > 0u ? cnt : 1u;
}
DI void xcd_barrier(const XcdBarrier& b) {
    asm volatile("s_waitcnt vmcnt(0)" ::: "memory");
    __syncthreads();
    if (threadIdx.x == 0) {
        unsigned* bar = b.bar;
        __builtin_amdgcn_s_waitcnt(0);
        unsigned nloc = b.st[0], nx = b.st[1];
        if (nloc == 0u) { xcd_barrier_complete(bar, b.x, nloc, nx); b.st[0] = nloc; b.st[1] = nx; }
        const unsigned old = xb_add(&bar[XB_XSUB(b.x)], 1u);
        const unsigned gen = old / nloc;
        if (old + 1u == (gen + 1u) * nloc) {
            __builtin_amdgcn_fence(__ATOMIC_RELEASE, "agent");
            asm volatile("s_waitcnt vmcnt(0)" ::: "memory");
            const unsigned og = xb_add(&bar[XB_TOP], 1u);
            const unsigned tg = og / nx;
            if (og + 1u == (tg + 1u) * nx) xb_add(&bar[XB_TOPGEN], 1u);
            else XB_SPIN(xb_ld(&bar[XB_TOPGEN]) == tg, bar);
            __builtin_amdgcn_fence(__ATOMIC_ACQUIRE, "agent");
            xb_add(&bar[XB_XGEN(b.x)], 1u);
            asm volatile("s_waitcnt vmcnt(0)" ::: "memory");
        } else {
            XB_SPIN(xb_ld(&bar[XB_XGEN(b.x)]) == gen, bar);
            __builtin_amdgcn_fence(__ATOMIC_ACQUIRE, "agent");
            asm volatile("s_waitcnt vmcnt(0)" ::: "memory");
        }
    }
    __syncthreads();
}

__global__ void __launch_bounds__(512, 2) fwd_kernel(Params prm) {
    extern __shared__ __attribute__((aligned(16))) unsigned char lds_raw[];
    cg::grid_group grid = cg::this_grid();
    Frame F; F.lds = (LAS unsigned char*)lds_raw; F.P = &prm; F.ws = prm.ws; F.tid = threadIdx.x; F.lane = F.tid & 63; F.wave = __builtin_amdgcn_readfirstlane(F.tid >> 6); F.G = gridDim.x; F.bid = blockIdx.x;
    const Params& P = prm;
    unsigned char* ws = prm.ws;
    const int gw = F.bid * 8 + F.wave, NGW = F.G * 8;
    const int lo = prm.ph_lo, hi = prm.ph_hi;
#define IN(k) (lo <= (k) && (k) < hi)
#define SEAM(k) do { if (IN(k) && IN((k) + 1)) { xcd_barrier(xbar); } } while (0)
    volatile LAS unsigned* xst = (volatile LAS unsigned*)(F.lds + 288 * 512 + 512);
    if (F.tid < 2) xst[F.tid] = 0u;
    __syncthreads();
    XcdBarrier xbar; xbar.bar = (unsigned*)(ws + WS_BAR); xbar.x = 0; xbar.st = xst;
    if (hi - lo > 1) xbar = xcd_barrier_post((unsigned*)(ws + WS_BAR), xst);
    if (lo > 4096) grid.sync();
#ifndef DUP_MASK
#define DUP_MASK 0
#endif
#define PH(k) for (int rep_ = 0; rep_ < (IN(k) ? 1 + ((DUP_MASK >> (k)) & 1) : 0); ++rep_)
    bf16_t* W1 = (bf16_t*)(ws + WS_WFF); bf16_t* XA = (bf16_t*)(ws + WS_XA); bf16_t* HID = (bf16_t*)(ws + WS_HID); float* H = (float*)(ws + WS_H);
    float* SSQ = (float*)(ws + WS_SSQ);

    PH(0) {
        LAS float* scr = (LAS float*)(F.lds + F.wave * 8704);
        for (int i = F.bid * 512 + F.tid; i < 3 * MR; i += F.G * 512) SSQ[i] = 0.f;
        if (F.bid == 0 && F.tid < 4) ((unsigned*)(ws + WS_CNT))[F.tid * 64] = 0u;
        for (int i = F.bid * 512 + F.tid; i < (MR - NTOK) * 1024 / 2; i += F.G * 512) ((unsigned*)((bf16_t*)(ws + WS_YS5P) + (size_t)NTOK * 1024))[i] = 0u;
        for (int it = gw; it < 32 * 264; it += NGW) { const int kb = it / 264, nb = it - kb * 264, d0 = nb * 32;
            int src = d0, nv = 32; if (d0 >= 8192) { src = 4096; nv = d0 == 8192 ? 8 : 0; } else if (d0 >= 4096) src = d0 + 8;
            tr_item(P.in[I_WIN], 8200, src, nv, (bf16_t*)(ws + WS_WIN), D, d0, kb * 64, scr, F.lane); }
        for (int it = gw; it < 16 * 32; it += NGW) { const int kb = it / 32, nb = it - kb * 32; tr_item(P.in[I_WGLU], 1024, nb * 32, 32, (bf16_t*)(ws + WS_WGLU), 1024, nb * 32, kb * 64, scr, F.lane); }
        for (int it = gw; it < 16 * 64; it += NGW) { const int kb = it / 64, nb = it - kb * 64; tr_item(P.in[I_WBS], 2048, nb * 32, 32, (bf16_t*)(ws + WS_WBS), 1024, nb * 32, kb * 64, scr, F.lane);
            tr_item(P.in[I_WBM], 2048, nb * 32, 32, (bf16_t*)(ws + WS_WBM), 1024, nb * 32, kb * 64, scr, F.lane); }
        for (int it = gw; it < 32 * 64; it += NGW) { const int kb = it / 64, nb = it - kb * 64; tr_item(P.in[I_WOUT], 2048, nb * 32, 32, (bf16_t*)(ws + WS_WOUT), 2048, nb * 32, kb * 64, scr, F.lane); }
        for (int it = gw; it < FFN_ITEMS; it += NGW) ffn_conv_item(P.in[I_F1G], P.in[I_F1U], P.in[I_F1D], W1, FFN_ITEMS - 1 - it, scr, F.lane);
        for (int r = gw; r < MR; r += NGW) rms_row(F, r, P.in[I_F1N], XA);
    }
    SEAM(0);
    PH(1) { pg8::Gemm g{XA, XA, W1, W1, D}; pg8::Order S; S.init(MR, 2 * DFF, F.G, F.bid, 1, 2); EpiSwiglu E{HID, nullptr}; pg8::gemm_phase(F.lds, g, S, E); }
    SEAM(1);
    PH(2) { pg8::Gemm g{HID, HID, W1 + (size_t)2 * DFF * D, W1 + (size_t)2 * DFF * D, DFF}; pg8::Order S; S.init(MR, D, F.G, F.bid, 1, 4);
        EpiResid<0> E{&prm}; pg8::gemm_phase(F.lds, g, S, E); }
    SEAM(2);
    PH(3) { const bf16_t* W = (const bf16_t*)(ws + WS_WIN); pg8::Gemm g{XA, XA, W, W, D}; pg8::Order S; S.init(MR, NIN, F.G, F.bid, 1, 1);
        EpiWin E{(float*)(ws + WS_US5), (float*)(ws + WS_QKPRE), HID + (size_t)MR * 4096, (bf16_t*)(ws + WS_SIGO), HID, (float*)(ws + WS_ZIF), SSQ}; pg8::gemm_phase(F.lds, g, S, E);
        if (F.bid >= 197) { s5_precompute(F, F.bid - 197); if (F.bid - 197 + 59 < 64) s5_precompute(F, F.bid - 197 + 59); } }
    SEAM(3);
    PH(4) {
        for (;;) { const int it = grab_item(F, (unsigned*)(ws + WS_CNT)); if (it >= NITEM + 320) break; if (it < 320) s5_item(F, it); else mlstm_prep(F, it - 320); }
        const float* QKPRE = (const float*)(ws + WS_QKPRE);
        for (int i = F.bid * 512 + F.tid; i < (NB + NS) * 3 * 1024; i += F.G * 512) { const int col = i & 1023, rr = i >> 10, j = rr % 3, b = rr / 3;
            if (b < NB) P.out[O_PCONV + ((size_t)b * 3 + j) * 1024 + col] = QKPRE[(size_t)(b * LP + LP - 3 + j) * 1024 + col];
            else P.out[O_SCONV + ((size_t)(b - NB) * 3 + j) * 1024 + col] = QKPRE[(size_t)(PROWS + (b - NB) * 8 + 5 + j) * 1024 + col]; }
    }
    SEAM(4);
    PH(5) mlstm_scan(F);
    SEAM(5);
    PH(6) {
        for (;;) { const int it = grab_item(F, (unsigned*)(ws + WS_CNT) + 64); if (it >= NITEM + NS * 4) break;
            if (it < NITEM) mlstm_out(F, it); else mlstm_sample(F, it - NITEM); }
        { LAS float* scr = (LAS float*)(F.lds + F.wave * 8704);
          for (;;) { const int it = grab_item(F, (unsigned*)(ws + WS_CNT) + 128); if (it >= FFN_ITEMS / 8) break;
              ffn_conv_item(P.in[I_F2G], P.in[I_F2U], P.in[I_F2D], W1, it * 8 + F.wave, scr, F.lane); } }
    }
    SEAM(6);
    PH(7) {
        bf16_t* YML = (bf16_t*)(ws + WS_QKPRE); bf16_t* YS5 = YML + (size_t)MR * 1024;
        const bf16_t* W = (const bf16_t*)(ws + WS_WGLU); const bf16_t* YP = (const bf16_t*)(ws + WS_YS5P);
        pg8::Gemm g{YP, YP, W, W, 1024}; pg8::Order S; S.init(MR, 1024, F.G, F.bid, 1, 1); EpiGlu E{YP, YS5}; pg8::gemm_phase(F.lds, g, S, E);
        const int nidle = F.G - 148;
        if (F.bid >= 148) for (int r = (F.bid - 148) * 8 + F.wave; r < MR; r += nidle * 8) yml_row(F, r);
    }
    SEAM(7);
    PH(8) { const bf16_t* YML = (const bf16_t*)(ws + WS_QKPRE); const bf16_t* YS5 = YML + (size_t)MR * 1024;
        pg8::Gemm g{YS5, YML, (const bf16_t*)(ws + WS_WBS), (const bf16_t*)(ws + WS_WBM), 1024}; pg8::Order S; S.init(MR, D, F.G, F.bid, 2, 4);
        EpiBranch E{HID, (bf16_t*)(ws + WS_US5)}; pg8::gemm_phase(F.lds, g, S, E); }
    SEAM(8);
    PH(9) { const bf16_t* MG = (const bf16_t*)(ws + WS_US5); const bf16_t* W = (const bf16_t*)(ws + WS_WOUT); pg8::Gemm g{MG, MG, W, W, D}; pg8::Order S; S.init(MR, D, F.G, F.bid, 1, 4);
        EpiResid<1> E{&prm}; pg8::gemm_phase(F.lds, g, S, E); }
    SEAM(9);
    PH(10) { pg8::Gemm g{XA, XA, W1, W1, D}; pg8::Order S; S.init(MR, 2 * DFF, F.G, F.bid, 1, 2); EpiSwiglu E{HID, SSQ + MR}; pg8::gemm_phase(F.lds, g, S, E); }
    SEAM(10);
    PH(11) { pg8::Gemm g{HID, HID, W1 + (size_t)2 * DFF * D, W1 + (size_t)2 * DFF * D, DFF}; pg8::Order S; S.init(MR, D, F.G, F.bid, 1, 4);
        EpiResid<2> E{&prm}; pg8::gemm_phase(F.lds, g, S, E); }
    SEAM(11);
    PH(12) {
        const f32x4* gn = (const f32x4*)P.in[I_FINN]; f32x4 gv[8];
#pragma unroll
        for (int j = 0; j < 8; ++j) gv[j] = gn[64 * j + F.lane];
        for (int r0 = gw; r0 < NTOK; r0 += 2 * NGW) {
            float* o[2]; bool ok[2]; float rs[2]; f32x4 hv[2][8];
#pragma unroll
            for (int q = 0; q < 2; ++q) { const int r = r0 + q * NGW; ok[q] = r < NTOK; o[q] = nullptr;
                if (ok[q]) { if (r < PROWS) { const int b = r / LP, t = r - b * LP; if (t < 16) ok[q] = false; else o[q] = P.out + O_YP + ((size_t)b * 2048 + (t - 16)) * D; } else o[q] = P.out + O_YS + (size_t)(r - PROWS) * D; }
                rs[q] = 0.f;
                if (ok[q]) { rs[q] = SSQ[2 * MR + r]; const f32x4* h = (const f32x4*)(H + (size_t)r * D);
#pragma unroll
                    for (int j = 0; j < 8; ++j) hv[q][j] = __builtin_nontemporal_load(h + 64 * j + F.lane); } }
#pragma unroll
            for (int q = 0; q < 2; ++q) if (ok[q]) { const float s = rsqrtf(rs[q] * (1.0f / D) + EPS);
#pragma unroll
                for (int j = 0; j < 8; ++j) __builtin_nontemporal_store(hv[q][j] * s * gv[j], (f32x4*)o[q] + 64 * j + F.lane); }
        }
    }
#undef IN
#undef SEAM
}

#ifndef N_LAUNCH_SPLIT
#define N_LAUNCH_SPLIT 0
#endif
#ifndef LAUNCH_LIST
#define LAUNCH_LIST {0, 1, 2, 3, 4, 5, 6, 7, 8, 9, 10, 11, 12}
#endif
extern "C" void kernel_launch(void* const* d_in, const int* in_sizes, int n_in, void* d_out, int out_size, void* d_ws, size_t ws_size, hipStream_t stream) {
    static int grid = 0;
    if (grid == 0) {
        if (n_in != 37 || (size_t)out_size != O_END || ws_size < WS_END) { fprintf(stderr, "kernel_launch: unexpected shapes (n_in %d, out %d, ws %zu, need %zu)\n", n_in, out_size, ws_size, (size_t)WS_END); grid = -1; return; }
        int dev = 0, cus = 0, per_cu = 0;
        hipGetDevice(&dev); hipDeviceGetAttribute(&cus, hipDeviceAttributeMultiprocessorCount, dev);
        if (hipFuncSetAttribute((const void*)fwd_kernel, hipFuncAttributeMaxDynamicSharedMemorySize, LDS_BYTES) != hipSuccess) { fprintf(stderr, "kernel_launch: hipFuncSetAttribute failed\n"); grid = -1; return; }
        if (hipOccupancyMaxActiveBlocksPerMultiprocessor(&per_cu, (const void*)fwd_kernel, 512, LDS_BYTES) != hipSuccess || per_cu < 1) per_cu = 1;
        (void)hipGetLastError();
        grid = cus;
    }
    if (grid < 0) return;
    Params p{};
    for (int i = 0; i < 37; ++i) p.in[i] = (const float*)d_in[i];
    p.out = (float*)d_out; p.ws = (unsigned char*)d_ws;
#if N_LAUNCH_SPLIT
    { const int plist[] = LAUNCH_LIST; for (int k : plist) { p.ph_lo = k; p.ph_hi = k + 1; hipLaunchKernelGGL(fwd_kernel, dim3(grid), dim3(512), LDS_BYTES, stream, p); } }
#else
    p.ph_lo = 0; p.ph_hi = 13;
    (void)hipMemsetAsync((char*)d_ws + WS_BAR, 0, 16384, stream);
    void* args[] = {&p};
    hipError_t e = hipLaunchCooperativeKernel((const void*)fwd_kernel, dim3(grid), dim3(512), args, LDS_BYTES, stream);
    if (e != hipSuccess) fprintf(stderr, "cooperative launch failed: %s (grid %d)\n", hipGetErrorString(e), grid);
#endif
}
```
